# Optimizing an MI355X kernel written in HIP

```python
import jax, jax.numpy as jnp
from jax import lax
import numpy as np

D_MODEL = 2048
BATCH = 4
SEQ = 2048
DEPTH = 2
DEC_BATCH = 128
DEC_SEQ = 8
PAST_LEN = 16384
PAGE_SIZE = 128

N_MIXERS = 2
N_LAYERS_A = (DEPTH + 1) // 2
N_LAYERS_B = DEPTH // 2
CONV_A_WIDTH = 3
GDN_HEAD_DIM = 128
GDN_QK_HEADS = D_MODEL // GDN_HEAD_DIM
GDN_V_HEADS = 2 * GDN_QK_HEADS
GDN_KEY_DIM = GDN_QK_HEADS * GDN_HEAD_DIM
GDN_VAL_DIM = GDN_V_HEADS * GDN_HEAD_DIM
GDN_CONV_DIM = 2 * GDN_KEY_DIM + GDN_VAL_DIM
GDN_PROJ_DIM = GDN_CONV_DIM + GDN_VAL_DIM + 2 * GDN_V_HEADS
CONV_B_WIDTH = 4
GDN_CHUNK = 64
D_FF = 4 * D_MODEL
EPS = 1e-6

kernel_name = "hybrid_shortconv_gdn_decode_step"


def _rmsnorm(x, w):
    xf = x.astype(jnp.float32)
    y = xf * lax.rsqrt(jnp.mean(xf * xf, axis=-1, keepdims=True) + EPS)
    return (y * w.astype(jnp.float32)).astype(x.dtype)


def _l2norm(x):
    return x * lax.rsqrt(jnp.sum(x * x, axis=-1, keepdims=True) + EPS)


def _causal_dwconv(xp, w, length):
    width = w.shape[0]
    y = xp[:, 0:length] * w[0]
    for j in range(1, width):
        y = y + xp[:, j:j + length] * w[j]
    return y


def _sqrelu_mlp(h, w_up, w_down):
    return jnp.square(jax.nn.relu(h @ w_up)) @ w_down


def _short_conv_mixer(h, buf, w_in, w_conv, w_out):
    gate_b, gate_c, xv = jnp.split(h @ w_in, 3, axis=-1)
    u = gate_c * xv
    up = jnp.concatenate([buf.astype(u.dtype), u], axis=1)
    y = _causal_dwconv(up, w_conv, h.shape[1])
    return (gate_b * y) @ w_out, up[:, -(CONV_A_WIDTH - 1):]


def _to_chunks(t, n, c):
    bsz = t.shape[0]
    t = t.reshape((bsz, n, c) + t.shape[2:])
    return jnp.transpose(t, (1, 0, 3, 2) + tuple(range(4, t.ndim)))


def _gated_delta_chunked(q, k, v, g, beta, s0):
    bsz, length, heads, dk = q.shape
    dv = v.shape[-1]
    c = min(GDN_CHUNK, length)
    n = -(-length // c)
    pad = n * c - length

    def prep(t):
        t = jnp.pad(t, [(0, 0), (0, pad)] + [(0, 0)] * (t.ndim - 2))
        return _to_chunks(t, n, c)

    qc, kc, vc, gc, bc = prep(q), prep(k), prep(v), prep(g), prep(beta)
    G = jnp.cumsum(gc, axis=-1)
    idx = jnp.arange(c)
    tril = idx[:, None] >= idx[None, :]
    strict = idx[:, None] > idx[None, :]
    decay = jnp.exp(jnp.where(tril, G[..., :, None] - G[..., None, :], -jnp.inf))
    kk = jnp.einsum('nbhid,nbhjd->nbhij', kc, kc)
    lmat = jnp.where(strict, bc[..., :, None] * kk * decay, 0.0)
    eye = jnp.eye(c, dtype=jnp.float32)
    rhs = jnp.concatenate([vc * bc[..., None], kc * (bc * jnp.exp(G))[..., None]], axis=-1)
    sol = lax.linalg.triangular_solve(eye + lmat, rhs, left_side=True, lower=True,
                                      unit_diagonal=True)
    u_c, w_c = sol[..., :dv], sol[..., dv:]
    qk = jnp.where(tril, jnp.einsum('nbhid,nbhjd->nbhij', qc, kc) * decay, 0.0)
    q_dec = qc * jnp.exp(G)[..., None]
    k_dec = kc * jnp.exp(G[..., -1:] - G)[..., None]
    g_last = jnp.exp(G[..., -1])

    def step(S, xs):
        qk_i, qd_i, kd_i, u_i, w_i, gl_i = xs
        v_new = u_i - jnp.einsum('bhcd,bhde->bhce', w_i, S)
        o_i = (jnp.einsum('bhcd,bhde->bhce', qd_i, S)
               + jnp.einsum('bhij,bhje->bhie', qk_i, v_new))
        S = S * gl_i[..., None, None] + jnp.einsum('bhcd,bhce->bhde', kd_i, v_new)
        return S, o_i

    s_fin, o = lax.scan(step, s0, (qk, q_dec, k_dec, u_c, w_c, g_last))
    o = jnp.transpose(o, (1, 0, 3, 2, 4)).reshape(bsz, n * c, heads, dv)[:, :length]
    return o, s_fin


def _gated_deltanet(h, buf, s0, w_in, w_conv, a_log, dt_bias, o_norm, w_out):
    bsz, length, _ = h.shape
    proj = h @ w_in
    o1 = GDN_CONV_DIM
    o2 = o1 + GDN_VAL_DIM
    o3 = o2 + GDN_V_HEADS
    qkv, z, b_raw, a_raw = proj[..., :o1], proj[..., o1:o2], proj[..., o2:o3], proj[..., o3:]
    qkv_p = jnp.concatenate([buf.astype(qkv.dtype), qkv], axis=1)
    qkv_c = jax.nn.silu(_causal_dwconv(qkv_p, w_conv, length)).astype(jnp.float32)
    q = qkv_c[..., :GDN_KEY_DIM].reshape(bsz, length, GDN_QK_HEADS, GDN_HEAD_DIM)
    k = qkv_c[..., GDN_KEY_DIM:2 * GDN_KEY_DIM].reshape(bsz, length, GDN_QK_HEADS, GDN_HEAD_DIM)
    v = qkv_c[..., 2 * GDN_KEY_DIM:].reshape(bsz, length, GDN_V_HEADS, GDN_HEAD_DIM)
    rep = GDN_V_HEADS // GDN_QK_HEADS
    q = jnp.repeat(_l2norm(q), rep, axis=2) * (GDN_HEAD_DIM ** -0.5)
    k = jnp.repeat(_l2norm(k), rep, axis=2)
    beta = jax.nn.sigmoid(b_raw.astype(jnp.float32))
    g = -jnp.exp(a_log.astype(jnp.float32)) * jax.nn.softplus(
        a_raw.astype(jnp.float32) + dt_bias.astype(jnp.float32))
    o, s_new = _gated_delta_chunked(q, k, v, g, beta, s0.astype(jnp.float32))
    gate = jax.nn.silu(z.astype(jnp.float32)).reshape(bsz, length, GDN_V_HEADS, GDN_HEAD_DIM)
    o = o * lax.rsqrt(jnp.mean(o * o, axis=-1, keepdims=True) + EPS) * o_norm.astype(jnp.float32) * gate
    out = o.reshape(bsz, length, GDN_VAL_DIM).astype(h.dtype) @ w_out
    return out, qkv_p[:, -(CONV_B_WIDTH - 1):], s_new.astype(h.dtype)


def _trunk(x, conv_a, conv_b, ssm_b, norm_a, w_in_a, w_conv_a, w_out_a, norm_b, w_in_b,
           w_conv_b, a_log_b, dt_bias_b, o_norm_b, w_out_b, mlp_norm, w_up, w_down, final_norm):
    new_a, new_cb, new_s = [], [], []
    for i in range(DEPTH):
        j = i // N_MIXERS
        if i % N_MIXERS == 0:
            mix, buf = _short_conv_mixer(_rmsnorm(x, norm_a[j]), conv_a[j],
                                         w_in_a[j], w_conv_a[j], w_out_a[j])
            new_a.append(buf)
        else:
            mix, buf, s = _gated_deltanet(_rmsnorm(x, norm_b[j]), conv_b[j], ssm_b[j], w_in_b[j],
                                          w_conv_b[j], a_log_b[j], dt_bias_b[j], o_norm_b[j],
                                          w_out_b[j])
            new_cb.append(buf)
            new_s.append(s)
        x = x + mix
        x = x + _sqrelu_mlp(_rmsnorm(x, mlp_norm[i]), w_up[i], w_down[i])
    return _rmsnorm(x, final_norm), jnp.stack(new_a), jnp.stack(new_cb), jnp.stack(new_s)


def setup_inputs(seed: int = 0) -> dict:
    key = jax.random.key(seed)
    ks = jax.random.split(key, 21)

    def nrm(k, shape, scale):
        return jax.random.normal(k, shape, jnp.float32) * scale

    def gain(k, shape):
        return 1.0 + 0.02 * jax.random.normal(k, shape, jnp.float32)

    dt = jnp.exp(jax.random.uniform(ks[13], (N_LAYERS_B, GDN_V_HEADS), jnp.float32,
                                    minval=float(np.log(1e-3)), maxval=float(np.log(1e-1))))
    dt_bias = dt + jnp.log(-jnp.expm1(-dt))
    return {
        "x_prompt": nrm(ks[0], (BATCH, SEQ, D_MODEL), 1.0),
        "x_sample": nrm(ks[1], (DEC_BATCH, DEC_SEQ, D_MODEL), 1.0),
        "state_conv_a": nrm(ks[2], (N_LAYERS_A, DEC_BATCH, CONV_A_WIDTH - 1, D_MODEL), 1.0),
        "state_conv_b": nrm(ks[3], (N_LAYERS_B, DEC_BATCH, CONV_B_WIDTH - 1, GDN_CONV_DIM), 1.0),
        "state_ssm_b": nrm(ks[4], (N_LAYERS_B, DEC_BATCH, GDN_V_HEADS, GDN_HEAD_DIM, GDN_HEAD_DIM), 0.05),
        "norm_a": gain(ks[5], (N_LAYERS_A, D_MODEL)),
        "w_in_a": nrm(ks[6], (N_LAYERS_A, D_MODEL, 3 * D_MODEL), D_MODEL ** -0.5),
        "w_conv_a": nrm(ks[7], (N_LAYERS_A, CONV_A_WIDTH, D_MODEL), CONV_A_WIDTH ** -0.5),
        "w_out_a": nrm(ks[8], (N_LAYERS_A, D_MODEL, D_MODEL), D_MODEL ** -0.5),
        "norm_b": gain(ks[9], (N_LAYERS_B, D_MODEL)),
        "w_in_b": nrm(ks[10], (N_LAYERS_B, D_MODEL, GDN_PROJ_DIM), D_MODEL ** -0.5),
        "w_conv_b": nrm(ks[11], (N_LAYERS_B, CONV_B_WIDTH, GDN_CONV_DIM), CONV_B_WIDTH ** -0.5),
        "a_log_b": jnp.log(jax.random.uniform(ks[12], (N_LAYERS_B, GDN_V_HEADS), jnp.float32,
                                               minval=1.0, maxval=16.0)),
        "dt_bias_b": dt_bias,
        "o_norm_b": gain(ks[14], (N_LAYERS_B, GDN_HEAD_DIM)),
        "w_out_b": nrm(ks[15], (N_LAYERS_B, GDN_VAL_DIM, D_MODEL), GDN_VAL_DIM ** -0.5),
        "mlp_norm": gain(ks[16], (DEPTH, D_MODEL)),
        "w_up": nrm(ks[17], (DEPTH, D_MODEL, D_FF), D_MODEL ** -0.5),
        "w_down": nrm(ks[18], (DEPTH, D_FF, D_MODEL), D_FF ** -0.5),
        "final_norm": gain(ks[19], (D_MODEL,)),
    }


def reference(x_prompt, x_sample, state_conv_a, state_conv_b, state_ssm_b, norm_a, w_in_a,
              w_conv_a, w_out_a, norm_b, w_in_b, w_conv_b, a_log_b, dt_bias_b, o_norm_b,
              w_out_b, mlp_norm, w_up, w_down, final_norm):
    bp = x_prompt.shape[0]
    zero_a = jnp.zeros((N_LAYERS_A, bp, CONV_A_WIDTH - 1, D_MODEL), x_prompt.dtype)
    zero_cb = jnp.zeros((N_LAYERS_B, bp, CONV_B_WIDTH - 1, GDN_CONV_DIM), x_prompt.dtype)
    zero_s = jnp.zeros((N_LAYERS_B, bp, GDN_V_HEADS, GDN_HEAD_DIM, GDN_HEAD_DIM), jnp.float32)
    y_prompt, conv_a_p, conv_b_p, ssm_b_p = _trunk(
        x_prompt, zero_a, zero_cb, zero_s, norm_a, w_in_a, w_conv_a, w_out_a, norm_b, w_in_b,
        w_conv_b, a_log_b, dt_bias_b, o_norm_b, w_out_b, mlp_norm, w_up, w_down, final_norm)
    y_sample, conv_a_s, conv_b_s, ssm_b_s = _trunk(
        x_sample, state_conv_a, state_conv_b, state_ssm_b, norm_a, w_in_a, w_conv_a, w_out_a,
        norm_b, w_in_b, w_conv_b, a_log_b, dt_bias_b, o_norm_b, w_out_b, mlp_norm, w_up,
        w_down, final_norm)
    return (y_prompt, y_sample, conv_a_p, conv_b_p, ssm_b_p, conv_a_s, conv_b_s, ssm_b_s)
```

```cpp
#include <hip/hip_runtime.h>
#include <hip/hip_cooperative_groups.h>
#include <cstdio>
#include <cstdint>
namespace cg = cooperative_groups;
namespace pg8 {
#define PG8_LAS __attribute__((address_space(3)))
typedef unsigned short bf16_t;
typedef short bf16x8 __attribute__((ext_vector_type(8)));
typedef float f32x4 __attribute__((ext_vector_type(4)));
typedef unsigned u32x4 __attribute__((ext_vector_type(4)));
constexpr int BM = 256, BK = 64, HALF = 128, HTB = HALF * BK * 2  , STAGE_BYTES = 8 * HTB, NXCD = 8, WGM = 8;

__host__ __device__ __forceinline__ int lds_byte(int r, int c) { const int st = (r >> 4) * 2 + (c >> 5), rr = r & 15, cc = c & 31, ob = rr * 64 + cc * 2; return st * 1024 + (ob ^ (((ob >> 9) & 1) << 5)); }
__host__ __device__ __forceinline__ void stage_rc(int b, int& R, int& C) { const int st = b / 1024, sb = b % 1024, swz = sb ^ (((sb >> 9) & 1) << 5); R = (st >> 1) * 16 + swz / 64; C = (st & 1) * 32 + (swz % 64) / 2; }
__host__ __device__ __forceinline__ int perm32(int rho) { const int n = rho >> 4, i = rho & 15; return 8 * (i >> 2) + 4 * n + (i & 3); }

struct Unit { int pm, pn; };
struct Gemm { const bf16_t* A; const bf16_t* Bt; int M, N, K; };

struct StaticOrder {
    int nM, nN, nwg, G, c;
    __host__ __device__ void init(int M, int N, int G_, int c_) { nM = M / BM; nN = N / BM; nwg = nM * nN; G = G_; c = c_; }
    __host__ __device__ bool next(int i, Unit& u) const {
        const long L = (long)i * G + c; if (L >= nwg) return false;
        int wgid = (int)L; { const int q = nwg / NXCD, r = nwg % NXCD, xcd = wgid % NXCD, off = wgid / NXCD; wgid = (xcd < r ? xcd * (q + 1) : r * (q + 1) + (xcd - r) * q) + off; }
        const int nig = WGM * nN, gid = wgid / nig, fm = gid * WGM, gsz = (nM - fm) < WGM ? (nM - fm) : WGM;
        u.pm = fm + ((wgid % nig) % gsz); u.pn = (wgid % nig) / gsz; return true;
    }
    __device__ __forceinline__ void a_ready(const Unit&) const {}
    __device__ __forceinline__ void done(const Unit&) const {}
};
typedef __bf16 bf16v2_t __attribute__((ext_vector_type(2)));
typedef float f32v2_t __attribute__((ext_vector_type(2)));
__device__ __forceinline__ unsigned cvt_pk_bf16(float lo, float hi) { const f32v2_t v = {lo, hi}; const bf16v2_t b = __builtin_convertvector(v, bf16v2_t); return __builtin_bit_cast(unsigned, b); }

template <class Epi, class Sched, bool STAMP = false>
__device__ __forceinline__ void gemm_phase(PG8_LAS unsigned char* lds, const Gemm g, const Sched& S, const Epi& E, unsigned long long* stamps) {
    const int tid = threadIdx.x, wid = __builtin_amdgcn_readfirstlane(tid >> 6), lane = tid & 63, wr = wid >> 2, wc = wid & 3, fr = lane & 15, fq = lane >> 4;
    const int K = g.K, nt = K / BK;
    int ts_lo = 0, ts_hi = 0, nts = 0; const unsigned long long rt_entry = STAMP ? (unsigned long long)wall_clock64() : 0ull;
#define PG8_STAMP() do { if (STAMP && wid == 0 && nts < 64) { const unsigned long long _c = (unsigned long long)clock64(); \
        ts_lo = (lane == nts) ? (int)(unsigned)_c : ts_lo; ts_hi = (lane == nts) ? (int)(unsigned)(_c >> 32) : ts_hi; ++nts; } } while (0)
    PG8_STAMP();
    unsigned voffA[2], voffB[2];
#pragma unroll
    for (int i = 0; i < 2; ++i) { int R, C; stage_rc(tid * 16 + i * 8192, R, C); const int Rb = Epi::PERM ? ((R & ~31) + perm32(R & 31)) : R;
        voffA[i] = (unsigned)(R * K + C) * 2u; voffB[i] = (unsigned)(Rb * K + C) * 2u; }
    const size_t kstep = (size_t)(BK * 2);
    const size_t hstep = (size_t)HALF * K * 2;
    const size_t tstep = 2 * hstep;
    const unsigned ldsw = (unsigned)wid * 1024u;
    const int aoff = lds_byte(wr * 64 + fr, fq * 8), boff = lds_byte(wc * 32 + fr, fq * 8);
#define PG8_SA(b, h) (((b) * 2 + (h)) * HTB)
#define PG8_SB(b, h) ((4 + (b) * 2 + (h)) * HTB)
#define PG8_STAGE(bufoff, gbase, voff) do { _Pragma("unroll") for (int _i = 0; _i < 2; ++_i) \
        __builtin_amdgcn_global_load_lds((const unsigned*)((const char*)(gbase) + (voff)[_i]), (PG8_LAS unsigned*)(lds + (bufoff) + ldsw + _i * 8192), 16, 0, 0); } while (0)
#define PG8_LDA(dst, b, h) do { _Pragma("unroll") for (int m = 0; m < 4; ++m) _Pragma("unroll") for (int k = 0; k < 2; ++k) dst[m][k] = *(const PG8_LAS bf16x8*)(lds + PG8_SA(b, h) + aoff + m * 2048 + k * 1024); } while (0)
#define PG8_LDB(dst, b, h) do { _Pragma("unroll") for (int n = 0; n < 2; ++n) _Pragma("unroll") for (int k = 0; k < 2; ++k) dst[n][k] = *(const PG8_LAS bf16x8*)(lds + PG8_SB(b, h) + boff + n * 2048 + k * 1024); } while (0)
#define PG8_MMA(ai, bj, At, Bt) do { __builtin_amdgcn_s_setprio(1); _Pragma("unroll") for (int m = 0; m < 4; ++m) _Pragma("unroll") for (int n = 0; n < 2; ++n) _Pragma("unroll") for (int k = 0; k < 2; ++k) \
        acc[ai][bj][m][n] = __builtin_amdgcn_mfma_f32_16x16x32_bf16(Bt[n][k], At[m][k], acc[ai][bj][m][n], 0, 0, 0); __builtin_amdgcn_s_setprio(0); } while (0)
#define PG8_WAIT_V(n) asm volatile("s_waitcnt vmcnt(" #n ")" ::: "memory")
#define PG8_WAIT_L(n) asm volatile("s_waitcnt lgkmcnt(" #n ")" ::: "memory")
#define PG8_BAR __builtin_amdgcn_s_barrier()
#define PG8_SCHED __builtin_amdgcn_sched_barrier(0)
    Unit cur, nxt; int ui = 0;
    if (!S.next(0, cur)) return;
    f32x4 acc[2][2][4][2];
#pragma unroll
    for (int a = 0; a < 2; ++a)
#pragma unroll
        for (int b = 0; b < 2; ++b)
#pragma unroll
            for (int m = 0; m < 4; ++m)
#pragma unroll
                for (int n = 0; n < 2; ++n) acc[a][b][m][n] = (f32x4){0.f, 0.f, 0.f, 0.f};
    bf16x8 At[4][2], B0[2][2], B1[2][2];
    const char* cA = (const char*)g.A + (size_t)cur.pm * tstep; const char* cB = (const char*)g.Bt + (size_t)cur.pn * tstep;
    S.a_ready(cur);
    PG8_STAGE(PG8_SB(0, 0), cB, voffB); PG8_STAGE(PG8_SA(0, 0), cA, voffA); PG8_STAGE(PG8_SB(0, 1), cB + hstep, voffB); PG8_STAGE(PG8_SA(0, 1), cA + hstep, voffA);
    if (wr == 1) PG8_BAR;
    PG8_WAIT_V(4); PG8_BAR;
    PG8_STAGE(PG8_SB(1, 0), cB + kstep, voffB); PG8_STAGE(PG8_SA(1, 0), cA + kstep, voffA); PG8_STAGE(PG8_SB(1, 1), cB + hstep + kstep, voffB);
    PG8_WAIT_V(6); PG8_BAR;
    PG8_STAMP();
    for (;;) {
        const bool has_next = S.next(ui + 1, nxt);
        const char* nA = has_next ? (const char*)g.A + (size_t)nxt.pm * tstep : cA; const char* nB = has_next ? (const char*)g.Bt + (size_t)nxt.pn * tstep : cB;
        for (int t = 0; t < nt; t += 2) {
            const bool last = (t == nt - 2);
            const char* a1 = cA + (size_t)(t + 1) * kstep;
            const char* a2 = last ? nA : cA + (size_t)(t + 2) * kstep; const char* b2 = last ? nB : cB + (size_t)(t + 2) * kstep;
            const char* a3 = a2 + kstep; const char* b3 = b2 + kstep;
            if (last && has_next) S.a_ready(nxt);
            PG8_LDB(B0, 0, 0); PG8_SCHED; PG8_LDA(At, 0, 0); PG8_STAGE(PG8_SA(1, 1), a1 + hstep, voffA);
            PG8_WAIT_L(8); PG8_BAR; PG8_WAIT_L(0); PG8_MMA(0, 0, At, B0); PG8_BAR; PG8_SCHED;
            PG8_LDB(B1, 0, 1); PG8_STAGE(PG8_SB(0, 0), b2, voffB);
            PG8_BAR; PG8_WAIT_L(0); PG8_MMA(0, 1, At, B1); PG8_BAR;
            PG8_LDA(At, 0, 1); PG8_STAGE(PG8_SA(0, 0), a2, voffA);
            PG8_BAR; PG8_WAIT_L(0); PG8_MMA(1, 0, At, B0); PG8_BAR; PG8_SCHED;
            PG8_STAGE(PG8_SB(0, 1), b2 + hstep, voffB);
            PG8_WAIT_V(6); PG8_BAR; PG8_MMA(1, 1, At, B1); PG8_BAR;
            PG8_LDB(B0, 1, 0); PG8_SCHED; PG8_LDA(At, 1, 0); PG8_STAGE(PG8_SA(0, 1), a2 + hstep, voffA);
            PG8_WAIT_L(8); PG8_BAR; PG8_WAIT_L(0); PG8_MMA(0, 0, At, B0); PG8_BAR; PG8_SCHED;
            PG8_LDB(B1, 1, 1); PG8_STAGE(PG8_SB(1, 0), b3, voffB);
            PG8_BAR; PG8_WAIT_L(0); PG8_MMA(0, 1, At, B1); PG8_BAR;
            PG8_LDA(At, 1, 1); PG8_STAGE(PG8_SA(1, 0), a3, voffA);
            PG8_BAR; PG8_WAIT_L(0); PG8_MMA(1, 0, At, B0); PG8_BAR; PG8_SCHED;
            PG8_STAGE(PG8_SB(1, 1), b3 + hstep, voffB);
            PG8_WAIT_V(6); PG8_BAR; PG8_MMA(1, 1, At, B1); PG8_BAR;
        }
        PG8_STAMP();
        if constexpr (!Epi::AFTER_DRAIN) { E(acc, cur, wr, wc, fr, fq); S.done(cur); }
        PG8_STAMP();
        if (!has_next) break;
#pragma unroll
        for (int a = 0; a < 2; ++a)
#pragma unroll
            for (int b = 0; b < 2; ++b)
#pragma unroll
                for (int m = 0; m < 4; ++m)
#pragma unroll
                    for (int n = 0; n < 2; ++n) acc[a][b][m][n] = (f32x4){0.f, 0.f, 0.f, 0.f};
        cur = nxt; cA = nA; cB = nB; ++ui;
    }
    PG8_WAIT_V(0);
    if (wr == 0) PG8_BAR;
    PG8_BAR;
    if constexpr (Epi::AFTER_DRAIN) { E.fused(acc, cur, wr, wc, fr, fq, lds, wid, lane); S.done(cur); }
    PG8_STAMP();
    if (STAMP && wid == 0) { stamps[lane] = lane < nts ? (((unsigned long long)(unsigned)ts_hi << 32) | (unsigned)ts_lo) : 0ull;
        if (lane == 62) stamps[62] = rt_entry; if (lane == 63) stamps[63] = (unsigned long long)wall_clock64(); }
#undef PG8_STAMP
#undef PG8_SA
#undef PG8_SB
#undef PG8_STAGE
#undef PG8_LDA
#undef PG8_LDB
#undef PG8_MMA
#undef PG8_WAIT_V
#undef PG8_WAIT_L
#undef PG8_BAR
#undef PG8_SCHED
}
}

using pg8::bf16_t; using pg8::bf16x8; using pg8::f32x4; using pg8::u32x4;
#define DEVI __device__ __forceinline__
#ifndef MEGA
#define MEGA 0
#endif

constexpr int D = 2048, TP = 8192, TS = 1024, T = 9216, DFF = 8192;
constexpr int NPROJ = 12352, NPROJ_PAD = 12544;
constexpr float EPS = 1e-6f;
constexpr int LDS_BYTES = 131072 + 4096;
constexpr int NCHAIN = 128;

constexpr size_t WS_WT_INA = 0;
constexpr size_t WS_WT_OUTA = WS_WT_INA + (size_t)6144 * 2048 * 2;
constexpr size_t WS_WT_UP0 = WS_WT_OUTA + (size_t)2048 * 2048 * 2;
constexpr size_t WS_WT_DN0 = WS_WT_UP0 + (size_t)8192 * 2048 * 2;
constexpr size_t WS_WT_INB = WS_WT_DN0 + (size_t)8192 * 2048 * 2;
constexpr size_t WS_WT_OUTB = WS_WT_INB + (size_t)NPROJ_PAD * 2048 * 2;
constexpr size_t WS_WT_UP1 = WS_WT_OUTB + (size_t)2048 * 4096 * 2;
constexpr size_t WS_WT_DN1 = WS_WT_UP1 + (size_t)8192 * 2048 * 2;
constexpr size_t WS_X = WS_WT_DN1 + (size_t)8192 * 2048 * 2;
constexpr size_t WS_H = WS_X + (size_t)T * D * 4;
constexpr size_t WS_GB = WS_H + (size_t)T * D * 2;
constexpr size_t WS_OG = WS_H;
constexpr size_t WS_ACT = WS_GB + (size_t)T * D * 2;
constexpr size_t WS_QKV = WS_ACT;
constexpr size_t WS_Z = WS_ACT + (size_t)T * 8192 * 2;
constexpr size_t WS_BA = WS_ACT + (size_t)T * 12288 * 2;
constexpr size_t WS_QN = WS_BA + (size_t)T * 64 * 4;
constexpr size_t WS_KN = WS_QN + (size_t)T * D * 2;
constexpr size_t WS_VS = WS_KN + (size_t)T * D * 2;
constexpr size_t WS_KT = WS_VS + (size_t)TS * 4096 * 2;
constexpr size_t WS_VT = WS_KT + (size_t)TP * 2048 * 2;
constexpr size_t WS_BETA = WS_VT + (size_t)TP * 4096 * 2;
constexpr size_t WS_GG = WS_BETA + (size_t)T * 32 * 4;
constexpr size_t WS_GC = WS_GG + (size_t)T * 32 * 4;
constexpr size_t WS_UT = WS_GC + (size_t)TP * 32 * 4;
constexpr size_t WS_WW = WS_UT + (size_t)TP * 4096 * 2;
constexpr size_t WS_QKM = WS_WW + (size_t)TP * 4096 * 2;
constexpr size_t WS_END = WS_QKM + (size_t)4096 * 4096 * 2;

constexpr size_t O_YP = 0;
constexpr size_t O_YS = O_YP + (size_t)TP * D;
constexpr size_t O_CAP = O_YS + (size_t)TS * D;
constexpr size_t O_CBP = O_CAP + (size_t)4 * 2 * 2048;
constexpr size_t O_SSP = O_CBP + (size_t)4 * 3 * 8192;
constexpr size_t O_CAS = O_SSP + (size_t)4 * 32 * 16384;
constexpr size_t O_CBS = O_CAS + (size_t)128 * 2 * 2048;
constexpr size_t O_SSS = O_CBS + (size_t)128 * 3 * 8192;

struct Params { const float* in[20]; float* out; unsigned char* ws; };

DEVI float bf2f(unsigned short b) { return __uint_as_float(((unsigned)b) << 16); }
DEVI unsigned pk2(float lo, float hi) { return pg8::cvt_pk_bf16(lo, hi); }
DEVI unsigned short f2bf(float f) { return (unsigned short)(pk2(f, 0.f) & 0xffffu); }
DEVI float wave_sum(float v) {
#pragma unroll
    for (int o = 1; o < 64; o <<= 1) v += __shfl_xor(v, o);
    return v;
}
DEVI void unpack8(u32x4 w, float (&f)[8]) {
    f[0] = __uint_as_float(w.x << 16); f[1] = __uint_as_float(w.x & 0xffff0000u);
    f[2] = __uint_as_float(w.y << 16); f[3] = __uint_as_float(w.y & 0xffff0000u);
    f[4] = __uint_as_float(w.z << 16); f[5] = __uint_as_float(w.z & 0xffff0000u);
    f[6] = __uint_as_float(w.w << 16); f[7] = __uint_as_float(w.w & 0xffff0000u);
}
DEVI u32x4 pack8(const float (&f)[8]) { u32x4 w; w.x = pk2(f[0], f[1]); w.y = pk2(f[2], f[3]); w.z = pk2(f[4], f[5]); w.w = pk2(f[6], f[7]); return w; }
DEVI void ld8f(const float* p, float (&f)[8]) { f32x4 a = *(const f32x4*)p, b = *(const f32x4*)(p + 4); f[0] = a.x; f[1] = a.y; f[2] = a.z; f[3] = a.w; f[4] = b.x; f[5] = b.y; f[6] = b.z; f[7] = b.w; }
DEVI void st8f(float* p, const float (&f)[8]) { *(f32x4*)p = (f32x4){f[0], f[1], f[2], f[3]}; *(f32x4*)(p + 4) = (f32x4){f[4], f[5], f[6], f[7]}; }
DEVI f32x4 mfma16(bf16x8 a, bf16x8 b, f32x4 c) { return __builtin_amdgcn_mfma_f32_16x16x32_bf16(a, b, c, 0, 0, 0); }
DEVI bf16x8 ldfrag(const bf16_t* p) { return *(const bf16x8*)p; }
#define WAVE_LDS_SYNC() do { asm volatile("s_waitcnt lgkmcnt(0)" ::: "memory"); __builtin_amdgcn_wave_barrier(); } while (0)

template <int ACT> struct EpiBf16 {
    static constexpr bool PERM = true, AFTER_DRAIN = false;
    bf16_t* O; int ldc;
    DEVI void operator()(const f32x4 (&acc)[2][2][4][2], const pg8::Unit& u, int wr, int wc, int fr, int fq) const {
        const int row0 = u.pm * 256 + wr * 64 + fr, col0 = u.pn * 256 + wc * 32 + 8 * fq;
#pragma unroll
        for (int ai = 0; ai < 2; ++ai)
#pragma unroll
            for (int m = 0; m < 4; ++m) { bf16_t* rowp = O + (size_t)(row0 + ai * 128 + m * 16) * ldc + col0;
#pragma unroll
                for (int bj = 0; bj < 2; ++bj) { f32x4 v0 = acc[ai][bj][m][0], v1 = acc[ai][bj][m][1];
                    if (ACT == 1) {
#pragma unroll
                        for (int j = 0; j < 4; ++j) { float a = fmaxf(v0[j], 0.f), b = fmaxf(v1[j], 0.f); v0[j] = a * a; v1[j] = b * b; } }
                    u32x4 w; w.x = pk2(v0[0], v0[1]); w.y = pk2(v0[2], v0[3]); w.z = pk2(v1[0], v1[1]); w.w = pk2(v1[2], v1[3]);
                    *(u32x4*)(rowp + bj * 128) = w; } }
    }
};
struct EpiResid {
    static constexpr bool PERM = false, AFTER_DRAIN = false;
    float* X; const float* rp; const float* rs;
    DEVI void operator()(const f32x4 (&acc)[2][2][4][2], const pg8::Unit& u, int wr, int wc, int fr, int fq) const {
        const int row0 = u.pm * 256 + wr * 64 + fr, col0 = u.pn * 256 + wc * 32 + 4 * fq;
        const float* R = (u.pm * 256 < TP) ? rp : (rs - (size_t)TP * D);
#pragma unroll
        for (int ai = 0; ai < 2; ++ai)
#pragma unroll
            for (int m = 0; m < 4; ++m) { const size_t ro = (size_t)(row0 + ai * 128 + m * 16) * D + col0;
#pragma unroll
                for (int bj = 0; bj < 2; ++bj)
#pragma unroll
                    for (int n = 0; n < 2; ++n) { const f32x4 r = *(const f32x4*)(R + ro + bj * 128 + n * 16); *(f32x4*)(X + ro + bj * 128 + n * 16) = acc[ai][bj][m][n] + r; } }
    }
};
struct EpiProj {
    static constexpr bool PERM = true, AFTER_DRAIN = false;
    bf16_t* QKV; bf16_t* Z; float* BA;
    DEVI void operator()(const f32x4 (&acc)[2][2][4][2], const pg8::Unit& u, int wr, int wc, int fr, int fq) const {
        const int row0 = u.pm * 256 + wr * 64 + fr; const int colt = u.pn * 256;
        if (colt < 12288) {
            bf16_t* base; int ldc, c0;
            if (colt < 8192) { base = QKV; ldc = 8192; c0 = colt; } else { base = Z; ldc = 4096; c0 = colt - 8192; }
            const int col0 = c0 + wc * 32 + 8 * fq;
#pragma unroll
            for (int ai = 0; ai < 2; ++ai)
#pragma unroll
                for (int m = 0; m < 4; ++m) { bf16_t* rowp = base + (size_t)(row0 + ai * 128 + m * 16) * ldc + col0;
#pragma unroll
                    for (int bj = 0; bj < 2; ++bj) { const f32x4 v0 = acc[ai][bj][m][0], v1 = acc[ai][bj][m][1];
                        u32x4 w; w.x = pk2(v0[0], v0[1]); w.y = pk2(v0[2], v0[3]); w.z = pk2(v1[0], v1[1]); w.w = pk2(v1[2], v1[3]);
                        *(u32x4*)(rowp + bj * 128) = w; } }
        } else if (wc < 2) {
#pragma unroll
            for (int ai = 0; ai < 2; ++ai)
#pragma unroll
                for (int m = 0; m < 4; ++m) { float* rowp = BA + (size_t)(row0 + ai * 128 + m * 16) * 64 + wc * 32 + 8 * fq;
                    *(f32x4*)(rowp) = acc[ai][0][m][0]; *(f32x4*)(rowp + 4) = acc[ai][0][m][1]; }
        }
    }
};

template <class Epi> DEVI void run_gemm(unsigned char* lds, const bf16_t* A, const bf16_t* Bt, int N, int K, const Epi& E, int bid, int nb) {
    pg8::Gemm g; g.A = A; g.Bt = Bt; g.M = T; g.N = N; g.K = K;
    pg8::StaticOrder S; S.init(T, N, nb, bid);
    pg8::gemm_phase<Epi, pg8::StaticOrder, false>((PG8_LAS unsigned char*)lds, g, S, E, nullptr);
}

DEVI void transpose_item(const float* W, int K, int N, bf16_t* WT, float* scr, int item, int lane) {
    const int nblk = N / 32, kb = item / nblk, nbk = item - kb * nblk, k0 = 64 * kb, n0 = 32 * nbk;
#pragma unroll 8
    for (int i = 0; i < 32; ++i) { const int kk = 2 * i + (lane >> 5); scr[kk * 33 + (lane & 31)] = W[(size_t)(k0 + kk) * N + n0 + (lane & 31)]; }
    WAVE_LDS_SYNC();
    const int c = lane & 7;
#pragma unroll
    for (int j = 0; j < 4; ++j) { const int n = (lane >> 3) + 8 * j; const float* s = scr + (8 * c) * 33 + n;
        u32x4 o; o.x = pk2(s[0 * 33], s[1 * 33]); o.y = pk2(s[2 * 33], s[3 * 33]); o.z = pk2(s[4 * 33], s[5 * 33]); o.w = pk2(s[6 * 33], s[7 * 33]);
        *(u32x4*)(WT + (size_t)(n0 + n) * K + k0 + 8 * c) = o; }
    WAVE_LDS_SYNC();
}
DEVI void rms_row_bf16(const float* xr, const float* w, bf16_t* o, int lane) {
    f32x4 v[8]; float s = 0.f;
#pragma unroll
    for (int j = 0; j < 8; ++j) { v[j] = ((const f32x4*)xr)[lane + 64 * j]; s += (v[j].x * v[j].x + v[j].y * v[j].y) + (v[j].z * v[j].z + v[j].w * v[j].w); }
    const float r = rsqrtf(wave_sum(s) * (1.f / D) + EPS);
#pragma unroll
    for (int j = 0; j < 8; ++j) { const f32x4 ww = ((const f32x4*)w)[lane + 64 * j];
        const unsigned lo = pk2(v[j].x * r * ww.x, v[j].y * r * ww.y), hi = pk2(v[j].z * r * ww.z, v[j].w * r * ww.w);
        ((unsigned long long*)o)[lane + 64 * j] = (unsigned long long)lo | ((unsigned long long)hi << 32); }
}
DEVI void rms_row_f32(const float* xr, const float* w, float* o, int lane) {
    f32x4 v[8]; float s = 0.f;
#pragma unroll
    for (int j = 0; j < 8; ++j) { v[j] = ((const f32x4*)xr)[lane + 64 * j]; s += (v[j].x * v[j].x + v[j].y * v[j].y) + (v[j].z * v[j].z + v[j].w * v[j].w); }
    const float r = rsqrtf(wave_sum(s) * (1.f / D) + EPS);
#pragma unroll
    for (int j = 0; j < 8; ++j) { const f32x4 ww = ((const f32x4*)w)[lane + 64 * j];
        ((f32x4*)o)[lane + 64 * j] = (f32x4){v[j].x * r * ww.x, v[j].y * r * ww.y, v[j].z * r * ww.z, v[j].w * r * ww.w}; }
}
DEVI void phase0(const Params& p, unsigned char* lds, int bid, int nb) {
    const int lane = threadIdx.x & 63, wave = threadIdx.x >> 6;
    float* scr = (float*)(lds + wave * 8448);
    const int gw = bid * 8 + wave, NGW = nb * 8;
    constexpr int I0 = 32 * 192, I1 = 32 * 64, I2 = 32 * 256, I3 = 128 * 64, I4 = 32 * 386, I5 = 64 * 64;
    constexpr int NITEMS = I0 + I1 + I2 + I3 + I4 + I5 + I2 + I3;
    unsigned char* ws = p.ws;
    for (int it = gw; it < NITEMS; it += NGW) {
        int r = it;
        if (r < I0) { transpose_item(p.in[6], 2048, 6144, (bf16_t*)(ws + WS_WT_INA), scr, r, lane); continue; } r -= I0;
        if (r < I1) { transpose_item(p.in[8], 2048, 2048, (bf16_t*)(ws + WS_WT_OUTA), scr, r, lane); continue; } r -= I1;
        if (r < I2) { transpose_item(p.in[17], 2048, 8192, (bf16_t*)(ws + WS_WT_UP0), scr, r, lane); continue; } r -= I2;
        if (r < I3) { transpose_item(p.in[18], 8192, 2048, (bf16_t*)(ws + WS_WT_DN0), scr, r, lane); continue; } r -= I3;
        if (r < I4) { transpose_item(p.in[10], 2048, NPROJ, (bf16_t*)(ws + WS_WT_INB), scr, r, lane); continue; } r -= I4;
        if (r < I5) { transpose_item(p.in[15], 4096, 2048, (bf16_t*)(ws + WS_WT_OUTB), scr, r, lane); continue; } r -= I5;
        if (r < I2) { transpose_item(p.in[17] + (size_t)2048 * 8192, 2048, 8192, (bf16_t*)(ws + WS_WT_UP1), scr, r, lane); continue; } r -= I2;
        transpose_item(p.in[18] + (size_t)8192 * 2048, 8192, 2048, (bf16_t*)(ws + WS_WT_DN1), scr, r, lane);
    }
    bf16_t* H = (bf16_t*)(ws + WS_H);
    for (int row = gw; row < T; row += NGW) {
        const float* src = row < TP ? p.in[0] + (size_t)row * D : p.in[1] + (size_t)(row - TP) * D;
        rms_row_bf16(src, p.in[5], H + (size_t)row * D, lane);
    }
}
DEVI void phase_rms(const Params& p, const float* w, int bid, int nb) {
    const int lane = threadIdx.x & 63, wave = threadIdx.x >> 6;
    const float* X = (const float*)(p.ws + WS_X); bf16_t* H = (bf16_t*)(p.ws + WS_H);
    for (int row = bid * 8 + wave; row < T; row += nb * 8) rms_row_bf16(X + (size_t)row * D, w, H + (size_t)row * D, lane);
}
DEVI void phase_rms_final(const Params& p, int bid, int nb) {
    const int lane = threadIdx.x & 63, wave = threadIdx.x >> 6;
    const float* X = (const float*)(p.ws + WS_X);
    for (int row = bid * 8 + wave; row < T; row += nb * 8) rms_row_f32(X + (size_t)row * D, p.in[19], p.out + O_YP + (size_t)row * D, lane);
}

DEVI void phase_conv_a(const Params& p, int bid, int nb) {
    const bf16_t* P1 = (const bf16_t*)(p.ws + WS_ACT); bf16_t* GBp = (bf16_t*)(p.ws + WS_GB);
    const float* wcv = p.in[7]; const float* st = p.in[2];
    for (int idx = bid * 512 + threadIdx.x; idx < T * 256; idx += nb * 512) {
        const int t = idx >> 8, c0 = (idx & 255) * 8;
        const bool smp = t >= TP; int b, pos, L;
        if (!smp) { b = t >> 11; pos = t & 2047; L = 2048; } else { const int s = t - TP; b = s >> 3; pos = s & 7; L = 8; }
        float w0[8], w1[8], w2[8]; ld8f(wcv + c0, w0); ld8f(wcv + 2048 + c0, w1); ld8f(wcv + 4096 + c0, w2);
        float gb[8], cc[8], xx[8], u0[8], u1[8], u2[8];
        const bf16_t* row = P1 + (size_t)t * 6144 + c0;
        unpack8(*(const u32x4*)(row), gb); unpack8(*(const u32x4*)(row + 2048), cc); unpack8(*(const u32x4*)(row + 4096), xx);
#pragma unroll
        for (int i = 0; i < 8; ++i) u0[i] = cc[i] * xx[i];
        if (pos >= 1) { unpack8(*(const u32x4*)(row - 6144 + 2048), cc); unpack8(*(const u32x4*)(row - 6144 + 4096), xx);
#pragma unroll
            for (int i = 0; i < 8; ++i) u1[i] = cc[i] * xx[i]; }
        else if (smp) ld8f(st + (size_t)(b * 2 + 1) * 2048 + c0, u1);
        else {
#pragma unroll
            for (int i = 0; i < 8; ++i) u1[i] = 0.f; }
        if (pos >= 2) { unpack8(*(const u32x4*)(row - 2 * 6144 + 2048), cc); unpack8(*(const u32x4*)(row - 2 * 6144 + 4096), xx);
#pragma unroll
            for (int i = 0; i < 8; ++i) u2[i] = cc[i] * xx[i]; }
        else if (smp) ld8f(st + (size_t)(b * 2 + pos) * 2048 + c0, u2);
        else {
#pragma unroll
            for (int i = 0; i < 8; ++i) u2[i] = 0.f; }
        float g[8];
#pragma unroll
        for (int i = 0; i < 8; ++i) g[i] = gb[i] * (w0[i] * u2[i] + w1[i] * u1[i] + w2[i] * u0[i]);
        *(u32x4*)(GBp + (size_t)t * 2048 + c0) = pack8(g);
        if (pos >= L - 2) { float* o = p.out + (smp ? O_CAS : O_CAP) + (size_t)(b * 2 + (pos - (L - 2))) * 2048 + c0; st8f(o, u0); }
    }
}

DEVI void phase_g1(const Params& p, int bid, int nb) {
    unsigned char* ws = p.ws;
    const bf16_t* QKV = (const bf16_t*)(ws + WS_QKV);
    bf16_t* QN = (bf16_t*)(ws + WS_QN); bf16_t* KN = (bf16_t*)(ws + WS_KN); bf16_t* VS = (bf16_t*)(ws + WS_VS);
    bf16_t* KT = (bf16_t*)(ws + WS_KT); bf16_t* VT = (bf16_t*)(ws + WS_VT);
    const float* wcv = p.in[11]; const float* st = p.in[3];
    for (int idx = bid * 512 + threadIdx.x; idx < (T / 8) * 1024; idx += nb * 512) {
        const int tg = idx >> 10, ch0 = (idx & 1023) * 8, t0 = tg * 8;
        const bool smp = t0 >= TP; int b, pos0;
        if (!smp) { b = t0 >> 11; pos0 = t0 & 2047; } else { b = (t0 - TP) >> 3; pos0 = 0; }
        float w0[8], w1[8], w2[8], w3[8]; ld8f(wcv + ch0, w0); ld8f(wcv + 8192 + ch0, w1); ld8f(wcv + 2 * 8192 + ch0, w2); ld8f(wcv + 3 * 8192 + ch0, w3);
        float h0[8], h1[8], h2[8];
        if (pos0 > 0) { const bf16_t* r = QKV + (size_t)t0 * 8192 + ch0; unpack8(*(const u32x4*)(r - 3 * 8192), h0); unpack8(*(const u32x4*)(r - 2 * 8192), h1); unpack8(*(const u32x4*)(r - 8192), h2); }
        else if (smp) { const float* r = st + (size_t)b * 3 * 8192 + ch0; ld8f(r, h0); ld8f(r + 8192, h1); ld8f(r + 2 * 8192, h2); }
        else {
#pragma unroll
            for (int i = 0; i < 8; ++i) { h0[i] = 0.f; h1[i] = 0.f; h2[i] = 0.f; } }
        float y[8][8];
        const bool tailp = (!smp) && (pos0 == 2040);
#pragma unroll
        for (int i = 0; i < 8; ++i) {
            float x[8]; unpack8(*(const u32x4*)(QKV + (size_t)(t0 + i) * 8192 + ch0), x);
#pragma unroll
            for (int c = 0; c < 8; ++c) { const float a = w0[c] * h0[c] + w1[c] * h1[c] + w2[c] * h2[c] + w3[c] * x[c]; y[i][c] = a / (1.f + __expf(-a)); h0[c] = h1[c]; h1[c] = h2[c]; h2[c] = x[c]; }
            if (i >= 5 && (smp || tailp)) { float* o = p.out + (smp ? O_CBS : O_CBP) + (size_t)(b * 3 + (i - 5)) * 8192 + ch0; st8f(o, x); }
        }
        if (ch0 < 4096) {
            const float sc = ch0 < 2048 ? 0.08838834764831845f : 1.f;
#pragma unroll
            for (int i = 0; i < 8; ++i) { float s = 0.f;
#pragma unroll
                for (int c = 0; c < 8; ++c) s += y[i][c] * y[i][c];
                s += __shfl_xor(s, 1); s += __shfl_xor(s, 2); s += __shfl_xor(s, 4); s += __shfl_xor(s, 8);
                const float r = rsqrtf(s + EPS) * sc;
#pragma unroll
                for (int c = 0; c < 8; ++c) y[i][c] *= r; }
        }
        if (ch0 < 2048) {
#pragma unroll
            for (int i = 0; i < 8; ++i) *(u32x4*)(QN + (size_t)(t0 + i) * 2048 + ch0) = pack8(y[i]);
        } else if (ch0 < 4096) {
            const int ck = ch0 - 2048;
#pragma unroll
            for (int i = 0; i < 8; ++i) *(u32x4*)(KN + (size_t)(t0 + i) * 2048 + ck) = pack8(y[i]);
            if (!smp) { const int n = pos0 >> 6, j0 = pos0 & 63, hk = ck >> 7, d0 = ck & 127;
                bf16_t* base = KT + ((size_t)((b * 32 + n) * 16 + hk) * 128 + d0) * 64 + j0;
#pragma unroll
                for (int c = 0; c < 8; ++c) { u32x4 w; w.x = pk2(y[0][c], y[1][c]); w.y = pk2(y[2][c], y[3][c]); w.z = pk2(y[4][c], y[5][c]); w.w = pk2(y[6][c], y[7][c]); *(u32x4*)(base + c * 64) = w; } }
        } else {
            const int cv = ch0 - 4096;
            if (smp) {
#pragma unroll
                for (int i = 0; i < 8; ++i) *(u32x4*)(VS + (size_t)(t0 - TP + i) * 4096 + cv) = pack8(y[i]);
            } else { const int n = pos0 >> 6, j0 = pos0 & 63, hv = cv >> 7, e0 = cv & 127;
                bf16_t* base = VT + ((size_t)((b * 32 + n) * 32 + hv) * 128 + e0) * 64 + j0;
#pragma unroll
                for (int c = 0; c < 8; ++c) { u32x4 w; w.x = pk2(y[0][c], y[1][c]); w.y = pk2(y[2][c], y[3][c]); w.z = pk2(y[4][c], y[5][c]); w.w = pk2(y[6][c], y[7][c]); *(u32x4*)(base + c * 64) = w; } }
        }
    }
    const float* BA = (const float*)(ws + WS_BA); float* BETA = (float*)(ws + WS_BETA); float* GG = (float*)(ws + WS_GG);
    for (int idx = bid * 512 + threadIdx.x; idx < T * 32; idx += nb * 512) {
        const int t = idx >> 5, h = idx & 31;
        const float br = BA[(size_t)t * 64 + h], ar = BA[(size_t)t * 64 + 32 + h];
        BETA[idx] = 1.f / (1.f + expf(-br));
        const float xs = ar + p.in[13][h];
        const float sp = fmaxf(xs, 0.f) + log1pf(expf(-fabsf(xs)));
        GG[idx] = -expf(p.in[12][h]) * sp;
    }
}

DEVI void phase_g2(const Params& p, unsigned char* lds, int bid, int nb) {
    unsigned char* ws = p.ws;
    const int lane = threadIdx.x & 63, wave = threadIdx.x >> 6, fr = lane & 15, fq = lane >> 4;
    float* Am = (float*)(lds + wave * 16384);
    const bf16_t* QN = (const bf16_t*)(ws + WS_QN); const bf16_t* KN = (const bf16_t*)(ws + WS_KN);
    const bf16_t* KT = (const bf16_t*)(ws + WS_KT); const bf16_t* VT = (const bf16_t*)(ws + WS_VT);
    const float* BETA = (const float*)(ws + WS_BETA); const float* GG = (const float*)(ws + WS_GG); float* GC = (float*)(ws + WS_GC);
    bf16_t* UT = (bf16_t*)(ws + WS_UT); bf16_t* WW = (bf16_t*)(ws + WS_WW); bf16_t* QKM = (bf16_t*)(ws + WS_QKM);
    for (int it = bid * 8 + wave; it < 4096; it += nb * 8) {
        const int b = it >> 10, n = (it >> 5) & 31, h = it & 31, hk = h >> 1, t0 = b * 2048 + n * 64;
        const size_t itemK = (size_t)((b * 32 + n) * 16 + hk);
        float gc = GG[(size_t)(t0 + lane) * 32 + h]; const float bt = BETA[(size_t)(t0 + lane) * 32 + h];
#pragma unroll
        for (int o = 1; o < 64; o <<= 1) { const float v = __shfl_up(gc, o); if (lane >= o) gc += v; }
        GC[(size_t)(t0 + lane) * 32 + h] = gc;
        const bf16_t* kbase = KN + (size_t)(t0 + fr) * 2048 + hk * 128 + 8 * fq;
        const bf16_t* qbase = QN + (size_t)(t0 + fr) * 2048 + hk * 128 + 8 * fq;
        {
#pragma unroll 1
            for (int m = 0; m < 4; ++m) {
                bf16x8 km[4];
#pragma unroll
                for (int kk = 0; kk < 4; ++kk) km[kk] = ldfrag(kbase + (size_t)(16 * m) * 2048 + 32 * kk);
#pragma unroll 1
                for (int nn = 0; nn < 4; ++nn) {
                    f32x4 acc = {0.f, 0.f, 0.f, 0.f};
                    if (nn <= m) {
#pragma unroll
                        for (int kk = 0; kk < 4; ++kk) acc = mfma16(km[kk], ldfrag(kbase + (size_t)(16 * nn) * 2048 + 32 * kk), acc); }
                    const int j = 16 * nn + fr; const float gj = __shfl(gc, j);
#pragma unroll
                    for (int jj = 0; jj < 4; ++jj) { const int i = 16 * m + 4 * fq + jj; const float gi = __shfl(gc, i), bi = __shfl(bt, i);
                        Am[i * 64 + j] = (i > j) ? -(bi * acc[jj] * __expf(gi - gj)) : 0.f; }
                }
            }
        }
        WAVE_LDS_SYNC();
        for (int i = 1; i < 64; ++i) {
            const float row = Am[i * 64 + lane]; float acc = row;
            for (int j = 0; j < i; ++j) { const float s = __int_as_float(__builtin_amdgcn_readlane(__float_as_int(row), j)); acc += s * Am[j * 64 + lane]; }
            Am[i * 64 + lane] = acc;
            WAVE_LDS_SYNC();
        }
        {
            bf16x8 tp[4][2], tpp[4][2];
#pragma unroll
            for (int kk = 0; kk < 2; ++kk) {
                float bj[8], bg[8];
#pragma unroll
                for (int s = 0; s < 8; ++s) { const int j = 32 * kk + 8 * fq + s; bj[s] = __shfl(bt, j); bg[s] = bj[s] * __expf(__shfl(gc, j)); }
#pragma unroll
                for (int mi = 0; mi < 4; ++mi) { const int i = 16 * mi + fr; float tv[8]; ld8f(Am + i * 64 + 32 * kk + 8 * fq, tv);
                    float a[8], c[8];
#pragma unroll
                    for (int s = 0; s < 8; ++s) { const float t = tv[s] + ((i == 32 * kk + 8 * fq + s) ? 1.f : 0.f); a[s] = t * bj[s]; c[s] = t * bg[s]; }
                    const u32x4 pa = pack8(a), pc = pack8(c); tp[mi][kk] = __builtin_bit_cast(bf16x8, pa); tpp[mi][kk] = __builtin_bit_cast(bf16x8, pc); }
            }
            const bf16_t* vtb = VT + (size_t)it * 8192 + (size_t)fr * 64 + 8 * fq; bf16_t* utb = UT + (size_t)it * 8192;
#pragma unroll 2
            for (int ne = 0; ne < 8; ++ne) { const bf16x8 v0 = ldfrag(vtb + ne * 1024), v1 = ldfrag(vtb + ne * 1024 + 32);
#pragma unroll
                for (int mi = 0; mi < 4; ++mi) { f32x4 acc = {0.f, 0.f, 0.f, 0.f}; acc = mfma16(tp[mi][0], v0, acc); acc = mfma16(tp[mi][1], v1, acc);
                    *(unsigned long long*)(utb + (size_t)(16 * ne + fr) * 64 + 16 * mi + 4 * fq) = (unsigned long long)pk2(acc[0], acc[1]) | ((unsigned long long)pk2(acc[2], acc[3]) << 32); } }
            const bf16_t* ktb = KT + itemK * 8192 + (size_t)fr * 64 + 8 * fq; bf16_t* wwb = WW + (size_t)it * 8192;
#pragma unroll 2
            for (int md = 0; md < 8; ++md) { const bf16x8 k0 = ldfrag(ktb + md * 1024), k1 = ldfrag(ktb + md * 1024 + 32);
#pragma unroll
                for (int ni = 0; ni < 4; ++ni) { f32x4 acc = {0.f, 0.f, 0.f, 0.f}; acc = mfma16(k0, tpp[ni][0], acc); acc = mfma16(k1, tpp[ni][1], acc);
                    *(unsigned long long*)(wwb + (size_t)(16 * ni + fr) * 128 + 16 * md + 4 * fq) = (unsigned long long)pk2(acc[0], acc[1]) | ((unsigned long long)pk2(acc[2], acc[3]) << 32); } }
        }
        asm volatile("" ::: "memory");
        {
            bf16_t* qkb = QKM + (size_t)it * 4096;
#pragma unroll 1
            for (int ni = 0; ni < 4; ++ni) {
                bf16x8 qn[4];
#pragma unroll
                for (int kk = 0; kk < 4; ++kk) qn[kk] = ldfrag(qbase + (size_t)(16 * ni) * 2048 + 32 * kk);
                const int i = 16 * ni + fr; const float gi = __shfl(gc, i);
#pragma unroll 1
                for (int mj = 0; mj < 4; ++mj) {
                    f32x4 acc = {0.f, 0.f, 0.f, 0.f};
                    if (ni >= mj) {
#pragma unroll
                        for (int kk = 0; kk < 4; ++kk) acc = mfma16(ldfrag(kbase + (size_t)(16 * mj) * 2048 + 32 * kk), qn[kk], acc); }
                    float o[4];
#pragma unroll
                    for (int jj = 0; jj < 4; ++jj) { const int j = 16 * mj + 4 * fq + jj; const float gj = __shfl(gc, j); o[jj] = (i >= j) ? acc[jj] * __expf(gi - gj) : 0.f; }
                    *(unsigned long long*)(qkb + (size_t)i * 64 + 16 * mj + 4 * fq) = (unsigned long long)pk2(o[0], o[1]) | ((unsigned long long)pk2(o[2], o[3]) << 32);
                }
            }
        }
        WAVE_LDS_SYNC();
    }
}

DEVI void g3_chain(const Params& p, unsigned char* lds, int item_bh) {
    unsigned char* ws = p.ws;
    const int tid = threadIdx.x, lane = tid & 63, w = tid >> 6, fr = lane & 15, fq = lane >> 4;
    const int b = item_bh >> 5, h = item_bh & 31, hk = h >> 1, m = w & 3, eh = w >> 2;
    bf16_t* St = (bf16_t*)lds; bf16_t* VNT = (bf16_t*)(lds + 34816); bf16_t* VNS = (bf16_t*)(lds + 34816 + 18432); float* RED = (float*)(lds + 34816 + 2 * 18432);
    const bf16_t* QN = (const bf16_t*)(ws + WS_QN); const bf16_t* KT = (const bf16_t*)(ws + WS_KT);
    const bf16_t* UT = (const bf16_t*)(ws + WS_UT); const bf16_t* WW = (const bf16_t*)(ws + WS_WW); const bf16_t* QKM = (const bf16_t*)(ws + WS_QKM);
    const float* GC = (const float*)(ws + WS_GC); const bf16_t* Z = (const bf16_t*)(ws + WS_Z); bf16_t* OG = (bf16_t*)(ws + WS_OG);
    const float* onorm = p.in[14];
    f32x4 s[2][4];
#pragma unroll
    for (int a = 0; a < 2; ++a)
#pragma unroll
        for (int c = 0; c < 4; ++c) { s[a][c] = (f32x4){0.f, 0.f, 0.f, 0.f};
            *(unsigned long long*)(St + (size_t)(16 * (4 * eh + c) + fr) * 136 + 16 * (2 * m + a) + 4 * fq) = 0ull; }
    __syncthreads();
    float on[4];
#pragma unroll
    for (int ne = 0; ne < 4; ++ne) on[ne] = onorm[16 * (4 * eh + ne) + fr];
    for (int n = 0; n < 32; ++n) {
        const size_t item = (size_t)((b * 32 + n) * 32 + h), itemK = (size_t)((b * 32 + n) * 16 + hk); const int t0 = b * 2048 + n * 64;
        bf16x8 wf[4], qf[4], qkf[2], ktf[2][2];
#pragma unroll
        for (int kk = 0; kk < 4; ++kk) { wf[kk] = ldfrag(WW + item * 8192 + (size_t)(16 * m + fr) * 128 + 32 * kk + 8 * fq); qf[kk] = ldfrag(QN + (size_t)(t0 + 16 * m + fr) * 2048 + hk * 128 + 32 * kk + 8 * fq); }
#pragma unroll
        for (int k2 = 0; k2 < 2; ++k2) { qkf[k2] = ldfrag(QKM + item * 4096 + (size_t)(16 * m + fr) * 64 + 32 * k2 + 8 * fq);
#pragma unroll
            for (int a = 0; a < 2; ++a) ktf[a][k2] = ldfrag(KT + itemK * 8192 + (size_t)(16 * (2 * m + a) + fr) * 64 + 32 * k2 + 8 * fq); }
        unsigned long long ut[4];
#pragma unroll
        for (int ne = 0; ne < 4; ++ne) ut[ne] = *(const unsigned long long*)(UT + item * 8192 + (size_t)(16 * (4 * eh + ne) + fr) * 64 + 16 * m + 4 * fq);
        float gi[4];
#pragma unroll
        for (int jj = 0; jj < 4; ++jj) gi[jj] = GC[(size_t)(t0 + 16 * m + 4 * fq + jj) * 32 + h];
        const float gl = GC[(size_t)(t0 + 63) * 32 + h];
        f32x4 P[4], O1[4];
#pragma unroll
        for (int ne = 0; ne < 4; ++ne) { P[ne] = (f32x4){0.f, 0.f, 0.f, 0.f}; O1[ne] = (f32x4){0.f, 0.f, 0.f, 0.f};
#pragma unroll
            for (int kk = 0; kk < 4; ++kk) { const bf16x8 bf = ldfrag(St + (size_t)(16 * (4 * eh + ne) + fr) * 136 + 32 * kk + 8 * fq); P[ne] = mfma16(wf[kk], bf, P[ne]); O1[ne] = mfma16(qf[kk], bf, O1[ne]); } }
        float eg[4], ed[4];
#pragma unroll
        for (int jj = 0; jj < 4; ++jj) { eg[jj] = __expf(gi[jj]); ed[jj] = __expf(gl - gi[jj]); }
#pragma unroll
        for (int ne = 0; ne < 4; ++ne) { float vn[4];
            vn[0] = bf2f((unsigned short)(ut[ne] & 0xffffu)) - P[ne][0]; vn[1] = bf2f((unsigned short)((ut[ne] >> 16) & 0xffffu)) - P[ne][1];
            vn[2] = bf2f((unsigned short)((ut[ne] >> 32) & 0xffffu)) - P[ne][2]; vn[3] = bf2f((unsigned short)((ut[ne] >> 48) & 0xffffu)) - P[ne][3];
            const size_t off = (size_t)(16 * (4 * eh + ne) + fr) * 72 + 16 * m + 4 * fq;
            *(unsigned long long*)(VNT + off) = (unsigned long long)pk2(vn[0], vn[1]) | ((unsigned long long)pk2(vn[2], vn[3]) << 32);
            *(unsigned long long*)(VNS + off) = (unsigned long long)pk2(vn[0] * ed[0], vn[1] * ed[1]) | ((unsigned long long)pk2(vn[2] * ed[2], vn[3] * ed[3]) << 32);
#pragma unroll
            for (int jj = 0; jj < 4; ++jj) O1[ne][jj] *= eg[jj]; }
        __syncthreads();
#pragma unroll
        for (int ne = 0; ne < 4; ++ne)
#pragma unroll
            for (int k2 = 0; k2 < 2; ++k2) { const bf16x8 bf = ldfrag(VNT + (size_t)(16 * (4 * eh + ne) + fr) * 72 + 32 * k2 + 8 * fq); O1[ne] = mfma16(qkf[k2], bf, O1[ne]); }
        float ss[4];
#pragma unroll
        for (int jj = 0; jj < 4; ++jj) { float v = O1[0][jj] * O1[0][jj] + O1[1][jj] * O1[1][jj] + O1[2][jj] * O1[2][jj] + O1[3][jj] * O1[3][jj];
            v += __shfl_xor(v, 1); v += __shfl_xor(v, 2); v += __shfl_xor(v, 4); v += __shfl_xor(v, 8); ss[jj] = v; }
        if (fr == 0) {
#pragma unroll
            for (int jj = 0; jj < 4; ++jj) RED[eh * 64 + 16 * m + 4 * fq + jj] = ss[jj]; }
        const float egl = __expf(gl);
#pragma unroll
        for (int a = 0; a < 2; ++a)
#pragma unroll
            for (int ne = 0; ne < 4; ++ne) { s[a][ne] = s[a][ne] * egl;
#pragma unroll
                for (int k2 = 0; k2 < 2; ++k2) { const bf16x8 bf = ldfrag(VNS + (size_t)(16 * (4 * eh + ne) + fr) * 72 + 32 * k2 + 8 * fq); s[a][ne] = mfma16(ktf[a][k2], bf, s[a][ne]); } }
        __syncthreads();
#pragma unroll
        for (int a = 0; a < 2; ++a)
#pragma unroll
            for (int ne = 0; ne < 4; ++ne)
                *(unsigned long long*)(St + (size_t)(16 * (4 * eh + ne) + fr) * 136 + 16 * (2 * m + a) + 4 * fq) = (unsigned long long)pk2(s[a][ne][0], s[a][ne][1]) | ((unsigned long long)pk2(s[a][ne][2], s[a][ne][3]) << 32);
#pragma unroll
        for (int jj = 0; jj < 4; ++jj) { const int i = 16 * m + 4 * fq + jj; const float r = rsqrtf((RED[i] + RED[64 + i]) * (1.f / 128.f) + EPS);
            const size_t ro = (size_t)(t0 + i) * 4096 + h * 128;
#pragma unroll
            for (int ne = 0; ne < 4; ++ne) { const int e = 16 * (4 * eh + ne) + fr; const float z = bf2f(Z[ro + e]);
                OG[ro + e] = f2bf(O1[ne][jj] * r * on[ne] * (z / (1.f + __expf(-z)))); } }
        __syncthreads();
    }
    float* so = p.out + O_SSP + (size_t)item_bh * 16384;
#pragma unroll
    for (int a = 0; a < 2; ++a)
#pragma unroll
        for (int ne = 0; ne < 4; ++ne)
#pragma unroll
            for (int jj = 0; jj < 4; ++jj) so[(size_t)(16 * (2 * m + a) + 4 * fq + jj) * 128 + 16 * (4 * eh + ne) + fr] = s[a][ne][jj];
}

DEVI void g3_sample(const Params& p, unsigned char* lds, int first, int stride) {
    unsigned char* ws = p.ws;
    const int tid = threadIdx.x, lane = tid & 63, w = tid >> 6, fr = lane & 15, fq = lane >> 4;
    bf16_t* St = (bf16_t*)lds;
    float* KF = (float*)(lds + 34816); float* QF = KF + 1024; float* VF = QF + 1024;
    float* SM = VF + 1024;
    float* gcs = SM; float* bts = SM + 8; float* M1 = SM + 16; float* QKs = SM + 80; float* Tm = SM + 144;
    bf16_t* AW = (bf16_t*)(SM + 256);
    float* UF = (float*)((unsigned char*)AW + 16 * 136 * 2);
    bf16_t* KDT = (bf16_t*)(UF + 1024);
    bf16_t* VNT = KDT + 1024;
    float* RED = (float*)(VNT + 1024);
    float* WSQ = RED + 64;
    const bf16_t* QN = (const bf16_t*)(ws + WS_QN); const bf16_t* KN = (const bf16_t*)(ws + WS_KN); const bf16_t* VS = (const bf16_t*)(ws + WS_VS);
    const float* BETA = (const float*)(ws + WS_BETA); const float* GG = (const float*)(ws + WS_GG);
    const bf16_t* Z = (const bf16_t*)(ws + WS_Z); bf16_t* OG = (bf16_t*)(ws + WS_OG);
    const float* s0 = p.in[4]; const float* onorm = p.in[14];
    f32x4 sreg[8], snext[8];
    if (first < 4096) {
#pragma unroll
        for (int mm = 0; mm < 8; ++mm) sreg[mm] = *(const f32x4*)(s0 + (size_t)first * 16384 + (size_t)(16 * mm + fr) * 128 + 16 * w + 4 * fq);
    }
    for (int it = first; it < 4096; it += stride) {
        const int bs = it >> 5, h = it & 31, hk = h >> 1, tS = TP + bs * 8;
#pragma unroll
        for (int mm = 0; mm < 8; ++mm)
#pragma unroll
            for (int jj = 0; jj < 4; ++jj) St[(size_t)(16 * w + 4 * fq + jj) * 136 + 16 * mm + fr] = f2bf(sreg[mm][jj]);
        if (it + stride < 4096) {
#pragma unroll
            for (int mm = 0; mm < 8; ++mm) snext[mm] = *(const f32x4*)(s0 + (size_t)(it + stride) * 16384 + (size_t)(16 * mm + fr) * 128 + 16 * w + 4 * fq);
        }
        { const int i = tid >> 6, d2 = (tid & 63) * 2;
          const unsigned kq = *(const unsigned*)(KN + (size_t)(tS + i) * 2048 + hk * 128 + d2); KF[i * 128 + d2] = __uint_as_float(kq << 16); KF[i * 128 + d2 + 1] = __uint_as_float(kq & 0xffff0000u);
          const unsigned qq = *(const unsigned*)(QN + (size_t)(tS + i) * 2048 + hk * 128 + d2); QF[i * 128 + d2] = __uint_as_float(qq << 16); QF[i * 128 + d2 + 1] = __uint_as_float(qq & 0xffff0000u);
          const unsigned vq = *(const unsigned*)(VS + (size_t)(bs * 8 + i) * 4096 + h * 128 + d2); VF[i * 128 + d2] = __uint_as_float(vq << 16); VF[i * 128 + d2 + 1] = __uint_as_float(vq & 0xffff0000u); }
        if (tid < 8) { float g = 0.f;
            for (int i = 0; i <= tid; ++i) g += GG[(size_t)(tS + i) * 32 + h];
            gcs[tid] = g; bts[tid] = BETA[(size_t)(tS + tid) * 32 + h]; }
        __syncthreads();
        { const int pid = tid >> 3, i = pid >> 3, j = pid & 7, part = tid & 7; float kkv = 0.f, qkv = 0.f;
#pragma unroll
          for (int d = 0; d < 16; ++d) { const float kj = KF[j * 128 + part * 16 + d]; kkv += KF[i * 128 + part * 16 + d] * kj; qkv += QF[i * 128 + part * 16 + d] * kj; }
          kkv += __shfl_xor(kkv, 1); kkv += __shfl_xor(kkv, 2); kkv += __shfl_xor(kkv, 4);
          qkv += __shfl_xor(qkv, 1); qkv += __shfl_xor(qkv, 2); qkv += __shfl_xor(qkv, 4);
          if (part == 0) { const float dg = gcs[i] - gcs[j]; const float e = (i >= j) ? __expf(dg) : 0.f;
              M1[i * 8 + j] = (i > j) ? bts[i] * kkv * e : 0.f; QKs[i * 8 + j] = qkv * e; } }
        __syncthreads();
        if (tid < 8) { float x[8];
#pragma unroll
            for (int i = 0; i < 8; ++i) { float a = (i == tid) ? 1.f : 0.f;
#pragma unroll
                for (int j = 0; j < 8; ++j) if (j < i) a -= M1[i * 8 + j] * x[j];
                x[i] = a; Tm[i * 8 + tid] = a; } }
        __syncthreads();
#pragma unroll
        for (int r = 0; r < 2; ++r) { const int idx = tid + 512 * r, i = idx >> 7, e = idx & 127; float a = 0.f, c = 0.f;
#pragma unroll
            for (int j = 0; j < 8; ++j) { const float tb = Tm[i * 8 + j] * bts[j]; a += tb * VF[j * 128 + e]; c += tb * __expf(gcs[j]) * KF[j * 128 + e]; }
            UF[idx] = a; AW[i * 136 + e] = f2bf(c); AW[(8 + i) * 136 + e] = f2bf(QF[idx]);
            KDT[e * 8 + i] = f2bf(KF[idx] * __expf(gcs[7] - gcs[i])); }
        __syncthreads();
        { f32x4 acc = {0.f, 0.f, 0.f, 0.f};
#pragma unroll
          for (int kk = 0; kk < 4; ++kk) acc = mfma16(ldfrag(AW + fr * 136 + 32 * kk + 8 * fq), ldfrag(St + (size_t)(16 * w + fr) * 136 + 32 * kk + 8 * fq), acc);
#pragma unroll
          for (int jj = 0; jj < 4; ++jj) WSQ[(4 * fq + jj) * 128 + 16 * w + fr] = acc[jj]; }
        WAVE_LDS_SYNC();
        const int e = 16 * w + fr;
        float vn[8], o2[2];
#pragma unroll
        for (int j = 0; j < 8; ++j) vn[j] = UF[j * 128 + e] - WSQ[j * 128 + e];
        if (fq == 0) *(u32x4*)(VNT + e * 8) = pack8(vn);
#pragma unroll
        for (int r = 0; r < 2; ++r) { const int i = 2 * fq + r; float o = __expf(gcs[i]) * WSQ[(8 + i) * 128 + e];
#pragma unroll
            for (int j = 0; j < 8; ++j) o += QKs[i * 8 + j] * vn[j];
            o2[r] = o; float v = o * o; v += __shfl_xor(v, 1); v += __shfl_xor(v, 2); v += __shfl_xor(v, 4); v += __shfl_xor(v, 8);
            if (fr == 0) RED[w * 8 + i] = v; }
        __syncthreads();
#pragma unroll
        for (int r = 0; r < 2; ++r) { const int i = 2 * fq + r; float tot = 0.f;
#pragma unroll
            for (int ww = 0; ww < 8; ++ww) tot += RED[ww * 8 + i];
            const float rr = rsqrtf(tot * (1.f / 128.f) + EPS); const size_t ro = (size_t)(tS + i) * 4096 + h * 128 + e; const float z = bf2f(Z[ro]);
            OG[ro] = f2bf(o2[r] * rr * onorm[e] * (z / (1.f + __expf(-z)))); }
        { const float egl = __expf(gcs[7]); bf16x8 af = {0, 0, 0, 0, 0, 0, 0, 0};
          if (fq == 0) af = ldfrag(VNT + (size_t)(16 * w + fr) * 8);
          float* so = p.out + O_SSS + (size_t)it * 16384;
#pragma unroll
          for (int mm = 0; mm < 8; ++mm) { bf16x8 bf = {0, 0, 0, 0, 0, 0, 0, 0}; if (fq == 0) bf = ldfrag(KDT + (size_t)(16 * mm + fr) * 8);
              f32x4 acc = sreg[mm] * egl; acc = mfma16(af, bf, acc);
              *(f32x4*)(so + (size_t)(16 * mm + fr) * 128 + 16 * w + 4 * fq) = acc; } }
#pragma unroll
        for (int mm = 0; mm < 8; ++mm) sreg[mm] = snext[mm];
        __syncthreads();
    }
}
DEVI void phase_g3(const Params& p, unsigned char* lds, int bid, int nb) {
    if (bid < NCHAIN) { for (int c = bid; c < 128; c += NCHAIN) g3_chain(p, lds, c); }
    else g3_sample(p, lds, bid - NCHAIN, nb - NCHAIN);
}

constexpr int NPHASES = 17;
template <int PH> DEVI void run_phase(const Params& p, unsigned char* lds, int bid, int nb) {
    unsigned char* ws = p.ws;
    bf16_t* H = (bf16_t*)(ws + WS_H); bf16_t* ACT = (bf16_t*)(ws + WS_ACT); float* X = (float*)(ws + WS_X);
    if constexpr (PH == 0) phase0(p, lds, bid, nb);
    else if constexpr (PH == 1) { EpiBf16<0> E; E.O = ACT; E.ldc = 6144; run_gemm(lds, H, (const bf16_t*)(ws + WS_WT_INA), 6144, 2048, E, bid, nb); }
    else if constexpr (PH == 2) phase_conv_a(p, bid, nb);
    else if constexpr (PH == 3) { EpiResid E; E.X = X; E.rp = p.in[0]; E.rs = p.in[1]; run_gemm(lds, (const bf16_t*)(ws + WS_GB), (const bf16_t*)(ws + WS_WT_OUTA), 2048, 2048, E, bid, nb); }
    else if constexpr (PH == 4) phase_rms(p, p.in[16], bid, nb);
    else if constexpr (PH == 5) { EpiBf16<1> E; E.O = ACT; E.ldc = 8192; run_gemm(lds, H, (const bf16_t*)(ws + WS_WT_UP0), 8192, 2048, E, bid, nb); }
    else if constexpr (PH == 6) { EpiResid E; E.X = X; E.rp = X; E.rs = X + (size_t)TP * D; run_gemm(lds, ACT, (const bf16_t*)(ws + WS_WT_DN0), 2048, 8192, E, bid, nb); }
    else if constexpr (PH == 7) phase_rms(p, p.in[9], bid, nb);
    else if constexpr (PH == 8) { EpiProj E; E.QKV = (bf16_t*)(ws + WS_QKV); E.Z = (bf16_t*)(ws + WS_Z); E.BA = (float*)(ws + WS_BA); run_gemm(lds, H, (const bf16_t*)(ws + WS_WT_INB), NPROJ_PAD, 2048, E, bid, nb); }
    else if constexpr (PH == 9) phase_g1(p, bid, nb);
    else if constexpr (PH == 10) phase_g2(p, lds, bid, nb);
    else if constexpr (PH == 11) phase_g3(p, lds, bid, nb);
    else if constexpr (PH == 12) { EpiResid E; E.X = X; E.rp = X; E.rs = X + (size_t)TP * D; run_gemm(lds, (const bf16_t*)(ws + WS_OG), (const bf16_t*)(ws + WS_WT_OUTB), 2048, 4096, E, bid, nb); }
    else if constexpr (PH == 13) phase_rms(p, p.in[16] + D, bid, nb);
    else if constexpr (PH == 14) { EpiBf16<1> E; E.O = ACT; E.ldc = 8192; run_gemm(lds, H, (const bf16_t*)(ws + WS_WT_UP1), 8192, 2048, E, bid, nb); }
    else if constexpr (PH == 15) { EpiResid E; E.X = X; E.rp = X; E.rs = X + (size_t)TP * D; run_gemm(lds, ACT, (const bf16_t*)(ws + WS_WT_DN1), 2048, 8192, E, bid, nb); }
    else if constexpr (PH == 16) phase_rms_final(p, bid, nb);
}

#if MEGA
__global__ void __launch_bounds__(512, 2) k_mega(Params p) {
    extern __shared__ __attribute__((aligned(16))) unsigned char shm[];
    cg::grid_group grid = cg::this_grid();
    const int bid = blockIdx.x, nb = gridDim.x;
    run_phase<0>(p, shm, bid, nb); grid.sync();
    run_phase<1>(p, shm, bid, nb); grid.sync();
    run_phase<2>(p, shm, bid, nb); grid.sync();
    run_phase<3>(p, shm, bid, nb); grid.sync();
    run_phase<4>(p, shm, bid, nb); grid.sync();
    run_phase<5>(p, shm, bid, nb); grid.sync();
    run_phase<6>(p, shm, bid, nb); grid.sync();
    run_phase<7>(p, shm, bid, nb); grid.sync();
    run_phase<8>(p, shm, bid, nb); grid.sync();
    run_phase<9>(p, shm, bid, nb); grid.sync();
    run_phase<10>(p, shm, bid, nb); grid.sync();
    run_phase<11>(p, shm, bid, nb); grid.sync();
    run_phase<12>(p, shm, bid, nb); grid.sync();
    run_phase<13>(p, shm, bid, nb); grid.sync();
    run_phase<14>(p, shm, bid, nb); grid.sync();
    run_phase<15>(p, shm, bid, nb); grid.sync();
    run_phase<16>(p, shm, bid, nb);
}
#else
template <int PH> __global__ void __launch_bounds__(512, 2) k_phase(Params p) {
    extern __shared__ __attribute__((aligned(16))) unsigned char shm[];
    run_phase<PH>(p, shm, blockIdx.x, gridDim.x);
}
template <int PH> static void launch_phase(const Params& p, int grid, hipStream_t stream) {
    static bool attr = false;
    if (!attr) { (void)hipFuncSetAttribute((const void*)k_phase<PH>, hipFuncAttributeMaxDynamicSharedMemorySize, LDS_BYTES); attr = true; }
    hipLaunchKernelGGL(k_phase<PH>, dim3(grid), dim3(512), LDS_BYTES, stream, p);
}
template <int PH> static void launch_all(const Params& p, int grid, hipStream_t stream) {
    launch_phase<PH>(p, grid, stream);
    if constexpr (PH + 1 < NPHASES) launch_all<PH + 1>(p, grid, stream);
}
#endif

extern "C" void kernel_launch(void* const* d_in, const int* in_sizes, int n_in, void* d_out, int out_size, void* d_ws, size_t ws_size, hipStream_t stream) {
    static int grid = 0;
    if (grid == 0) {
        if (n_in != 20 || ws_size < WS_END) { fprintf(stderr, "kernel_launch: need 20 inputs and %zu bytes of workspace (got %d, %zu)\n", (size_t)WS_END, n_in, ws_size); grid = -1; return; }
        int dev = 0, cus = 0, per_cu = 0;
        (void)hipGetDevice(&dev); (void)hipDeviceGetAttribute(&cus, hipDeviceAttributeMultiprocessorCount, dev);
#if MEGA
        if (hipFuncSetAttribute((const void*)k_mega, hipFuncAttributeMaxDynamicSharedMemorySize, LDS_BYTES) != hipSuccess) { fprintf(stderr, "kernel_launch: hipFuncSetAttribute failed\n"); grid = -1; return; }
        if (hipOccupancyMaxActiveBlocksPerMultiprocessor(&per_cu, (const void*)k_mega, 512, LDS_BYTES) != hipSuccess || per_cu < 1) { fprintf(stderr, "kernel_launch: occupancy query says %d blocks per CU\n", per_cu); grid = -1; return; }
#endif
        grid = cus;
        if (grid < NCHAIN + 1) { fprintf(stderr, "kernel_launch: %d CUs is too few\n", grid); grid = -1; return; }
    }
    if (grid < 0) return;
    Params p{};
    for (int i = 0; i < 20; ++i) p.in[i] = (const float*)d_in[i];
    p.out = (float*)d_out; p.ws = (unsigned char*)d_ws;
#if MEGA
    void* args[] = {&p};
    hipError_t e = hipLaunchCooperativeKernel((const void*)k_mega, dim3(grid), dim3(512), args, LDS_BYTES, stream);
    if (e != hipSuccess) fprintf(stderr, "kernel_launch: cooperative launch failed: %s (grid %d)\n", hipGetErrorString(e), grid);
#else
    launch_all<0>(p, grid, stream);
#endif
}
```

```cpp
#include <hip/hip_runtime.h>
#include <hip/hip_cooperative_groups.h>
#include <cstdio>
#include <cstdint>
#include <type_traits>
namespace cg = cooperative_groups;
namespace pg8 {
#define PG8_LAS __attribute__((address_space(3)))
typedef unsigned short bf16_t;
typedef short bf16x8 __attribute__((ext_vector_type(8)));
typedef float f32x4 __attribute__((ext_vector_type(4)));
typedef unsigned u32x4 __attribute__((ext_vector_type(4)));
constexpr int BM = 256, BK = 64, HALF = 128, HTB = HALF * BK * 2  , STAGE_BYTES = 8 * HTB, NXCD = 8, WGM = 8;

__host__ __device__ __forceinline__ int lds_byte(int r, int c) { const int st = (r >> 4) * 2 + (c >> 5), rr = r & 15, cc = c & 31, ob = rr * 64 + cc * 2; return st * 1024 + (ob ^ (((ob >> 9) & 1) << 5)); }
__host__ __device__ __forceinline__ void stage_rc(int b, int& R, int& C) { const int st = b / 1024, sb = b % 1024, swz = sb ^ (((sb >> 9) & 1) << 5); R = (st >> 1) * 16 + swz / 64; C = (st & 1) * 32 + (swz % 64) / 2; }
__host__ __device__ __forceinline__ int perm32(int rho) { const int n = rho >> 4, i = rho & 15; return 8 * (i >> 2) + 4 * n + (i & 3); }

struct Unit { int pm, pn, kt0, nt; };
struct Gemm { const bf16_t* A; const bf16_t* Bt; int M, N, K; };

struct StaticOrder {
    int nM, nN, nwg, G, c, ntk;
    __host__ __device__ void init(int M, int N, int G_, int c_, int K_) { nM = M / BM; nN = N / BM; nwg = nM * nN; G = G_; c = c_; ntk = K_ / BK; }
    __host__ __device__ bool next(int i, Unit& u) const {
        const long L = (long)i * G + c; if (L >= nwg) return false;
        int wgid = (int)L; { const int q = nwg / NXCD, r = nwg % NXCD, xcd = wgid % NXCD, off = wgid / NXCD; wgid = (xcd < r ? xcd * (q + 1) : r * (q + 1) + (xcd - r) * q) + off; }
        const int nig = WGM * nN, gid = wgid / nig, fm = gid * WGM, gsz = (nM - fm) < WGM ? (nM - fm) : WGM;
        u.pm = fm + ((wgid % nig) % gsz); u.pn = (wgid % nig) / gsz; u.kt0 = 0; u.nt = ntk; return true;
    }
    __device__ __forceinline__ void a_ready(const Unit&) const {}
    __device__ __forceinline__ void done(const Unit&) const {}
};
typedef __bf16 bf16v2_t __attribute__((ext_vector_type(2)));
typedef float f32v2_t __attribute__((ext_vector_type(2)));
__device__ __forceinline__ unsigned cvt_pk_bf16(float lo, float hi) { const f32v2_t v = {lo, hi}; const bf16v2_t b = __builtin_convertvector(v, bf16v2_t); return __builtin_bit_cast(unsigned, b); }

template <class Epi, class Sched, bool STAMP = false>
__device__ __forceinline__ void gemm_phase(PG8_LAS unsigned char* lds, const Gemm g, const Sched& S, const Epi& E, unsigned long long* stamps) {
    int tid_ = (int)threadIdx.x; asm volatile("" : "+v"(tid_)); const int tid = tid_, wid = __builtin_amdgcn_readfirstlane(tid >> 6), lane = tid & 63, wr = wid >> 2, wc = wid & 3, fr = lane & 15, fq = lane >> 4;
    const int K = g.K;
    int ts_lo = 0, ts_hi = 0, nts = 0; const unsigned long long rt_entry = STAMP ? (unsigned long long)wall_clock64() : 0ull;
#define PG8_STAMP() do { if (STAMP && wid == 0 && nts < 64) { const unsigned long long _c = (unsigned long long)clock64(); \
        ts_lo = (lane == nts) ? (int)(unsigned)_c : ts_lo; ts_hi = (lane == nts) ? (int)(unsigned)(_c >> 32) : ts_hi; ++nts; } } while (0)
    PG8_STAMP();
    unsigned voffA[2], voffB[2];
#pragma unroll
    for (int i = 0; i < 2; ++i) { int R, C; stage_rc(tid * 16 + i * 8192, R, C); const int Rb = Epi::PERM ? ((R & ~31) + perm32(R & 31)) : R;
        voffA[i] = (unsigned)(R * K + C) * 2u; voffB[i] = (unsigned)(Rb * K + C) * 2u; }
    const size_t kstep = (size_t)(BK * 2);
    const size_t hstep = (size_t)HALF * K * 2;
    const size_t tstep = 2 * hstep;
    const unsigned ldsw = (unsigned)wid * 1024u;
    const int aoff = lds_byte(wr * 64 + fr, fq * 8), boff = lds_byte(wc * 32 + fr, fq * 8);
#define PG8_SA(b, h) (((b) * 2 + (h)) * HTB)
#define PG8_SB(b, h) ((4 + (b) * 2 + (h)) * HTB)
#define PG8_STAGE(bufoff, gbase, voff) do { _Pragma("unroll") for (int _i = 0; _i < 2; ++_i) \
        __builtin_amdgcn_global_load_lds((const unsigned*)((const char*)(gbase) + (voff)[_i]), (PG8_LAS unsigned*)(lds + (bufoff) + ldsw + _i * 8192), 16, 0, 0); } while (0)
#define PG8_LDA(dst, b, h) do { _Pragma("unroll") for (int m = 0; m < 4; ++m) _Pragma("unroll") for (int k = 0; k < 2; ++k) dst[m][k] = *(const PG8_LAS bf16x8*)(lds + PG8_SA(b, h) + aoff + m * 2048 + k * 1024); } while (0)
#define PG8_LDB(dst, b, h) do { _Pragma("unroll") for (int n = 0; n < 2; ++n) _Pragma("unroll") for (int k = 0; k < 2; ++k) dst[n][k] = *(const PG8_LAS bf16x8*)(lds + PG8_SB(b, h) + boff + n * 2048 + k * 1024); } while (0)
#define PG8_MMA(ai, bj, At, Bt) do { __builtin_amdgcn_s_setprio(1); _Pragma("unroll") for (int m = 0; m < 4; ++m) _Pragma("unroll") for (int n = 0; n < 2; ++n) _Pragma("unroll") for (int k = 0; k < 2; ++k) \
        acc[ai][bj][m][n] = __builtin_amdgcn_mfma_f32_16x16x32_bf16(Bt[n][k], At[m][k], acc[ai][bj][m][n], 0, 0, 0); __builtin_amdgcn_s_setprio(0); } while (0)
#define PG8_WAIT_V(n) asm volatile("s_waitcnt vmcnt(" #n ")" ::: "memory")
#define PG8_WAIT_L(n) asm volatile("s_waitcnt lgkmcnt(" #n ")" ::: "memory")
#define PG8_BAR __builtin_amdgcn_s_barrier()
#define PG8_SCHED __builtin_amdgcn_sched_barrier(0)
    Unit cur, nxt; int ui = 0;
    if (!S.next(0, cur)) return;
    f32x4 acc[2][2][4][2];
#pragma unroll
    for (int a = 0; a < 2; ++a)
#pragma unroll
        for (int b = 0; b < 2; ++b)
#pragma unroll
            for (int m = 0; m < 4; ++m)
#pragma unroll
                for (int n = 0; n < 2; ++n) acc[a][b][m][n] = (f32x4){0.f, 0.f, 0.f, 0.f};
    bf16x8 At[4][2], B0[2][2], B1[2][2];
    const char* cA = (const char*)g.A + (size_t)cur.pm * tstep + (size_t)cur.kt0 * kstep; const char* cB = (const char*)g.Bt + (size_t)cur.pn * tstep + (size_t)cur.kt0 * kstep;
    S.a_ready(cur);
    PG8_STAGE(PG8_SB(0, 0), cB, voffB); PG8_STAGE(PG8_SA(0, 0), cA, voffA); PG8_STAGE(PG8_SB(0, 1), cB + hstep, voffB); PG8_STAGE(PG8_SA(0, 1), cA + hstep, voffA);
    if (wr == 1) PG8_BAR;
    PG8_WAIT_V(4); PG8_BAR;
    PG8_STAGE(PG8_SB(1, 0), cB + kstep, voffB); PG8_STAGE(PG8_SA(1, 0), cA + kstep, voffA); PG8_STAGE(PG8_SB(1, 1), cB + hstep + kstep, voffB);
    PG8_WAIT_V(6); PG8_BAR;
    PG8_STAMP();
    for (;;) {
        const bool has_next = S.next(ui + 1, nxt);
        const char* nA = has_next ? (const char*)g.A + (size_t)nxt.pm * tstep + (size_t)nxt.kt0 * kstep : cA; const char* nB = has_next ? (const char*)g.Bt + (size_t)nxt.pn * tstep + (size_t)nxt.kt0 * kstep : cB;
        const int nt = cur.nt;
        for (int t = 0; t < nt; t += 2) {
            const bool last = (t == nt - 2);
            const char* a1 = cA + (size_t)(t + 1) * kstep;
            const char* a2 = last ? nA : cA + (size_t)(t + 2) * kstep; const char* b2 = last ? nB : cB + (size_t)(t + 2) * kstep;
            const char* a3 = a2 + kstep; const char* b3 = b2 + kstep;
            if (last && has_next) S.a_ready(nxt);
            PG8_LDB(B0, 0, 0); PG8_SCHED; PG8_LDA(At, 0, 0); PG8_STAGE(PG8_SA(1, 1), a1 + hstep, voffA);
            PG8_WAIT_L(8); PG8_BAR; PG8_WAIT_L(0); PG8_MMA(0, 0, At, B0); PG8_BAR; PG8_SCHED;
            PG8_LDB(B1, 0, 1); PG8_STAGE(PG8_SB(0, 0), b2, voffB);
            PG8_BAR; PG8_WAIT_L(0); PG8_MMA(0, 1, At, B1); PG8_BAR;
            PG8_LDA(At, 0, 1); PG8_STAGE(PG8_SA(0, 0), a2, voffA);
            PG8_BAR; PG8_WAIT_L(0); PG8_MMA(1, 0, At, B0); PG8_BAR; PG8_SCHED;
            PG8_STAGE(PG8_SB(0, 1), b2 + hstep, voffB);
            PG8_WAIT_V(6); PG8_BAR; PG8_MMA(1, 1, At, B1); PG8_BAR;
            PG8_LDB(B0, 1, 0); PG8_SCHED; PG8_LDA(At, 1, 0); PG8_STAGE(PG8_SA(0, 1), a2 + hstep, voffA);
            PG8_WAIT_L(8); PG8_BAR; PG8_WAIT_L(0); PG8_MMA(0, 0, At, B0); PG8_BAR; PG8_SCHED;
            PG8_LDB(B1, 1, 1); PG8_STAGE(PG8_SB(1, 0), b3, voffB);
            PG8_BAR; PG8_WAIT_L(0); PG8_MMA(0, 1, At, B1); PG8_BAR;
            PG8_LDA(At, 1, 1); PG8_STAGE(PG8_SA(1, 0), a3, voffA);
            PG8_BAR; PG8_WAIT_L(0); PG8_MMA(1, 0, At, B0); PG8_BAR; PG8_SCHED;
            PG8_STAGE(PG8_SB(1, 1), b3 + hstep, voffB);
            PG8_WAIT_V(6); PG8_BAR; PG8_MMA(1, 1, At, B1); PG8_BAR;
        }
        PG8_STAMP();
        if constexpr (!Epi::AFTER_DRAIN) { E(acc, cur, wr, wc, fr, fq); S.done(cur); }
        PG8_STAMP();
        if (!has_next) break;
#pragma unroll
        for (int a = 0; a < 2; ++a)
#pragma unroll
            for (int b = 0; b < 2; ++b)
#pragma unroll
                for (int m = 0; m < 4; ++m)
#pragma unroll
                    for (int n = 0; n < 2; ++n) acc[a][b][m][n] = (f32x4){0.f, 0.f, 0.f, 0.f};
        cur = nxt; cA = nA; cB = nB; ++ui;
    }
    PG8_WAIT_V(0);
    if (wr == 0) PG8_BAR;
    PG8_BAR;
    if constexpr (Epi::AFTER_DRAIN) { E.fused(acc, cur, wr, wc, fr, fq, lds, wid, lane); S.done(cur); }
    PG8_STAMP();
    if (STAMP && wid == 0) { stamps[lane] = lane < nts ? (((unsigned long long)(unsigned)ts_hi << 32) | (unsigned)ts_lo) : 0ull;
        if (lane == 62) stamps[62] = rt_entry; if (lane == 63) stamps[63] = (unsigned long long)wall_clock64(); }
#undef PG8_STAMP
#undef PG8_SA
#undef PG8_SB
#undef PG8_STAGE
#undef PG8_LDA
#undef PG8_LDB
#undef PG8_MMA
#undef PG8_WAIT_V
#undef PG8_WAIT_L
#undef PG8_BAR
#undef PG8_SCHED
}
}

#define XB_TMO      128
#define XB_XCNT(j)  (256  + 64 * (j))
#define XB_XSUB(j)  (1280 + 64 * (j))
#define XB_XGEN(j)  (2304 + 64 * (j))
#define XB_TOP      3328
#define XB_TOPGEN   3392
#define XCD_BAR_WORDS 3456
#define XB_SPIN_CAP (1u << 18)
#define LAS __attribute__((address_space(3)))

__device__ __forceinline__ unsigned xb_ld(unsigned* p)              { return __hip_atomic_load(p, __ATOMIC_RELAXED, __HIP_MEMORY_SCOPE_AGENT); }
__device__ __forceinline__ unsigned xb_add(unsigned* p, unsigned v) { return __hip_atomic_fetch_add(p, v, __ATOMIC_RELAXED, __HIP_MEMORY_SCOPE_AGENT); }
__device__ __forceinline__ unsigned xb_xcc_id() { return (unsigned)__builtin_amdgcn_s_getreg((3 << 11) | 20) & 0xFu; }
#define XB_SPIN(cond, bar) do { unsigned _sp = 0; while (cond) { __builtin_amdgcn_s_sleep(1); \
    if ((++_sp & 255u) == 0u) { if (xb_ld(&(bar)[XB_TMO])) break; if (_sp > XB_SPIN_CAP) { atomicAdd(&(bar)[XB_TMO], 1u); break; } } } } while (0)

struct XcdBarrier {
    unsigned* bar; unsigned x;
    volatile LAS unsigned* st;
};

__device__ __forceinline__ XcdBarrier xcd_barrier_post(unsigned* bar, volatile LAS unsigned* st) {
    XcdBarrier b; b.bar = bar; b.x = xb_xcc_id(); b.st = st;
    if (threadIdx.x == 0) (void)xb_add(&bar[XB_XCNT(b.x)], 1u);
    return b;
}
__device__ __forceinline__ void xcd_barrier_complete(unsigned* bar, unsigned x, unsigned& nloc, unsigned& nx) {
    const unsigned G = gridDim.x * gridDim.y * gridDim.z;
    unsigned sum, cnt, mine, sp = 0u;
    for (;;) {
        sum = 0u; cnt = 0u; mine = 0u;
#pragma unroll
        for (unsigned j = 0; j < 16; ++j) { const unsigned c = xb_ld(&bar[XB_XCNT(j)]); sum += c; cnt += (c > 0u) ? 1u : 0u; mine = (j == x) ? c : mine; }
        if (sum == G) break;
        __builtin_amdgcn_s_sleep(1);
        if ((++sp & 255u) == 0u) { if (xb_ld(&bar[XB_TMO])) break; if (sp > XB_SPIN_CAP) { atomicAdd(&bar[XB_TMO], 1u); break; } }
    }
    nloc = mine > 0u ? mine : 1u; nx = cnt > 0u ? cnt : 1u;
}

__device__ __forceinline__ void xcd_barrier(const XcdBarrier& b) {
    asm volatile("s_waitcnt vmcnt(0)" ::: "memory");
    __syncthreads();
    if (threadIdx.x == 0) {
        unsigned* bar = b.bar;
        __builtin_amdgcn_s_waitcnt(0);
        unsigned nloc = b.st[0], nx = b.st[1];
        if (nloc == 0u) { xcd_barrier_complete(bar, b.x, nloc, nx); b.st[0] = nloc; b.st[1] = nx; }
        const unsigned old = xb_add(&bar[XB_XSUB(b.x)], 1u);
        const unsigned gen = old / nloc;
        if (old + 1u == (gen + 1u) * nloc) {
            __builtin_amdgcn_fence(__ATOMIC_RELEASE, "agent");
            asm volatile("s_waitcnt vmcnt(0)" ::: "memory");
            const unsigned og = xb_add(&bar[XB_TOP], 1u);
            const unsigned tg = og / nx;
            if (og + 1u == (tg + 1u) * nx) xb_add(&bar[XB_TOPGEN], 1u);
            else XB_SPIN(xb_ld(&bar[XB_TOPGEN]) == tg, bar);
            __builtin_amdgcn_fence(__ATOMIC_ACQUIRE, "agent");
            xb_add(&bar[XB_XGEN(b.x)], 1u);
            asm volatile("s_waitcnt vmcnt(0)" ::: "memory");
        } else {
            XB_SPIN(xb_ld(&bar[XB_XGEN(b.x)]) == gen, bar);
            __builtin_amdgcn_fence(__ATOMIC_ACQUIRE, "agent");
            asm volatile("s_waitcnt vmcnt(0)" ::: "memory");
        }
    }
    __syncthreads();
}

using pg8::bf16_t; using pg8::bf16x8; using pg8::f32x4; using pg8::u32x4;
#define DEVI __device__ __forceinline__
DEVI int otid() { int t = (int)hipThreadIdx_x; asm volatile("" : "+v"(t)); return t; }
#ifndef MEGA
#define MEGA 1
#endif

constexpr int D = 2048, TP = 8192, TS = 1024, T = 9216, DFF = 8192;
constexpr int NPROJ = 12352, NPROJ_PAD = 12544;
constexpr float EPS = 1e-6f;
constexpr int LDS_XB = 73728 + 65536;
constexpr int LDS_BYTES = LDS_XB + 16;
constexpr int NCHAIN = 128;
constexpr int NS_A = 32 * 128;

constexpr size_t WS_WT_INA = 0;
constexpr size_t WS_WT_OUTA = WS_WT_INA + (size_t)6144 * 2048 * 2;
constexpr size_t WS_WT_UP0 = WS_WT_OUTA + (size_t)2048 * 2048 * 2;
constexpr size_t WS_WT_DN0 = WS_WT_UP0 + (size_t)8192 * 2048 * 2;
constexpr size_t WS_WT_INB = WS_WT_DN0 + (size_t)8192 * 2048 * 2;
constexpr size_t WS_WT_OUTB = WS_WT_INB + (size_t)NPROJ_PAD * 2048 * 2;
constexpr size_t WS_WT_UP1 = WS_WT_OUTB + (size_t)2048 * 4096 * 2;
constexpr size_t WS_WT_DN1 = WS_WT_UP1 + (size_t)8192 * 2048 * 2;
constexpr size_t WS_X = WS_WT_DN1 + (size_t)8192 * 2048 * 2;
constexpr size_t WS_H = WS_X + (size_t)T * D * 4;
constexpr size_t WS_GB = WS_H + (size_t)T * D * 2;
constexpr size_t WS_OG = WS_H;
constexpr size_t WS_ACT = WS_GB + (size_t)T * D * 2;
constexpr size_t WS_QKV = WS_ACT;
constexpr size_t WS_Z = WS_ACT + (size_t)T * 8192 * 2;
constexpr size_t WS_BA = WS_ACT + (size_t)T * 12288 * 2;
constexpr size_t WS_QN = WS_BA + (size_t)T * 64 * 4;
constexpr size_t WS_KN = WS_QN + (size_t)T * D * 2;
constexpr size_t WS_VS = WS_KN + (size_t)T * D * 2;
constexpr size_t WS_KT = WS_VS + (size_t)TS * 4096 * 2;
constexpr size_t WS_VT = WS_KT + (size_t)TP * 2048 * 2;
constexpr size_t WS_BETA = WS_VT + (size_t)TP * 4096 * 2;
constexpr size_t WS_GG = WS_BETA + (size_t)T * 32 * 4;
constexpr size_t WS_GC = WS_GG + (size_t)T * 32 * 4;
constexpr size_t WS_UT = WS_GC + (size_t)TP * 32 * 4;
constexpr size_t WS_WW = WS_UT + (size_t)TP * 4096 * 2;
constexpr size_t WS_QKM = WS_WW + (size_t)TP * 4096 * 2;
constexpr size_t WS_PB = WS_QKM + (size_t)4096 * 4096 * 2;
constexpr size_t WS_PA = WS_PB + (size_t)T * D * 2;
constexpr size_t WS_BAR = WS_PB + (size_t)T * D * 4;
constexpr size_t WS_END = WS_BAR + 16384;

constexpr size_t O_YP = 0;
constexpr size_t O_YS = O_YP + (size_t)TP * D;
constexpr size_t O_CAP = O_YS + (size_t)TS * D;
constexpr size_t O_CBP = O_CAP + (size_t)4 * 2 * 2048;
constexpr size_t O_SSP = O_CBP + (size_t)4 * 3 * 8192;
constexpr size_t O_CAS = O_SSP + (size_t)4 * 32 * 16384;
constexpr size_t O_CBS = O_CAS + (size_t)128 * 2 * 2048;
constexpr size_t O_SSS = O_CBS + (size_t)128 * 3 * 8192;

struct Params { const float* in[20]; float* out; unsigned char* ws; };

DEVI float bf2f(unsigned short b) { return __uint_as_float(((unsigned)b) << 16); }
DEVI unsigned pk2(float lo, float hi) { return pg8::cvt_pk_bf16(lo, hi); }
DEVI unsigned short f2bf(float f) { return (unsigned short)(pk2(f, 0.f) & 0xffffu); }
DEVI float silu_f(float a) { return a * __builtin_amdgcn_rcpf(1.f + __expf(-a)); }
DEVI float wave_sum(float v) {
#pragma unroll
    for (int o = 1; o < 64; o <<= 1) v += __shfl_xor(v, o);
    return v;
}
DEVI void unpack8(u32x4 w, float (&f)[8]) {
    f[0] = __uint_as_float(w.x << 16); f[1] = __uint_as_float(w.x & 0xffff0000u);
    f[2] = __uint_as_float(w.y << 16); f[3] = __uint_as_float(w.y & 0xffff0000u);
    f[4] = __uint_as_float(w.z << 16); f[5] = __uint_as_float(w.z & 0xffff0000u);
    f[6] = __uint_as_float(w.w << 16); f[7] = __uint_as_float(w.w & 0xffff0000u);
}
DEVI u32x4 pack8(const float (&f)[8]) { u32x4 w; w.x = pk2(f[0], f[1]); w.y = pk2(f[2], f[3]); w.z = pk2(f[4], f[5]); w.w = pk2(f[6], f[7]); return w; }
DEVI void ld8f(const float* p, float (&f)[8]) { f32x4 a = *(const f32x4*)p, b = *(const f32x4*)(p + 4); f[0] = a.x; f[1] = a.y; f[2] = a.z; f[3] = a.w; f[4] = b.x; f[5] = b.y; f[6] = b.z; f[7] = b.w; }
DEVI void st8f(float* p, const float (&f)[8]) { *(f32x4*)p = (f32x4){f[0], f[1], f[2], f[3]}; *(f32x4*)(p + 4) = (f32x4){f[4], f[5], f[6], f[7]}; }
DEVI f32x4 mfma16(bf16x8 a, bf16x8 b, f32x4 c) { return __builtin_amdgcn_mfma_f32_16x16x32_bf16(a, b, c, 0, 0, 0); }
DEVI bf16x8 ldfrag(const bf16_t* p) { return *(const bf16x8*)p; }
#define LDS_BARRIER() do { asm volatile("s_waitcnt lgkmcnt(0)" ::: "memory"); __builtin_amdgcn_s_barrier(); asm volatile("" ::: "memory"); } while (0)
#define WAVE_LDS_SYNC() do { asm volatile("s_waitcnt lgkmcnt(0)" ::: "memory"); __builtin_amdgcn_wave_barrier(); } while (0)

template <int ACT> struct EpiBf16 {
    static constexpr bool PERM = true, AFTER_DRAIN = false;
    bf16_t* O; int ldc;
    DEVI void operator()(const f32x4 (&acc)[2][2][4][2], const pg8::Unit& u, int wr, int wc, int fr, int fq) const {
        const int row0 = u.pm * 256 + wr * 64 + fr, col0 = u.pn * 256 + wc * 32 + 8 * fq;
#pragma unroll
        for (int ai = 0; ai < 2; ++ai)
#pragma unroll
            for (int m = 0; m < 4; ++m) { bf16_t* rowp = O + (size_t)(row0 + ai * 128 + m * 16) * ldc + col0;
#pragma unroll
                for (int bj = 0; bj < 2; ++bj) { f32x4 v0 = acc[ai][bj][m][0], v1 = acc[ai][bj][m][1];
                    if (ACT == 1) {
#pragma unroll
                        for (int j = 0; j < 4; ++j) { float a = fmaxf(v0[j], 0.f), b = fmaxf(v1[j], 0.f); v0[j] = a * a; v1[j] = b * b; } }
                    u32x4 w; w.x = pk2(v0[0], v0[1]); w.y = pk2(v0[2], v0[3]); w.z = pk2(v1[0], v1[1]); w.w = pk2(v1[2], v1[3]);
                    *(u32x4*)(rowp + bj * 128) = w; } }
    }
};
struct EpiResid {
    static constexpr bool PERM = false, AFTER_DRAIN = false;
    float* X; const float* rp; const float* rs;
    DEVI void operator()(const f32x4 (&acc)[2][2][4][2], const pg8::Unit& u, int wr, int wc, int fr, int fq) const {
        const int row0 = u.pm * 256 + wr * 64 + fr, col0 = u.pn * 256 + wc * 32 + 4 * fq;
        const float* R = (u.pm * 256 < TP) ? rp : (rs - (size_t)TP * D);
#pragma unroll
        for (int ai = 0; ai < 2; ++ai)
#pragma unroll
            for (int m = 0; m < 4; ++m) { const size_t ro = (size_t)(row0 + ai * 128 + m * 16) * D + col0;
#pragma unroll
                for (int bj = 0; bj < 2; ++bj)
#pragma unroll
                    for (int n = 0; n < 2; ++n) { const f32x4 r = *(const f32x4*)(R + ro + bj * 128 + n * 16); *(f32x4*)(X + ro + bj * 128 + n * 16) = acc[ai][bj][m][n] + r; } }
    }
};
struct EpiProj {
    static constexpr bool PERM = true, AFTER_DRAIN = false;
    bf16_t* QKV; bf16_t* Z; float* BA;
    DEVI void operator()(const f32x4 (&acc)[2][2][4][2], const pg8::Unit& u, int wr, int wc, int fr, int fq) const {
        const int row0 = u.pm * 256 + wr * 64 + fr; const int colt = u.pn * 256;
        if (colt < 12288) {
            bf16_t* base; int ldc, c0;
            if (colt < 8192) { base = QKV; ldc = 8192; c0 = colt; } else { base = Z; ldc = 4096; c0 = colt - 8192; }
            const int col0 = c0 + wc * 32 + 8 * fq;
#pragma unroll
            for (int ai = 0; ai < 2; ++ai)
#pragma unroll
                for (int m = 0; m < 4; ++m) { bf16_t* rowp = base + (size_t)(row0 + ai * 128 + m * 16) * ldc + col0;
#pragma unroll
                    for (int bj = 0; bj < 2; ++bj) { const f32x4 v0 = acc[ai][bj][m][0], v1 = acc[ai][bj][m][1];
                        u32x4 w; w.x = pk2(v0[0], v0[1]); w.y = pk2(v0[2], v0[3]); w.z = pk2(v1[0], v1[1]); w.w = pk2(v1[2], v1[3]);
                        *(u32x4*)(rowp + bj * 128) = w; } }
        } else if (wc < 2) {
#pragma unroll
            for (int ai = 0; ai < 2; ++ai)
#pragma unroll
                for (int m = 0; m < 4; ++m) { float* rowp = BA + (size_t)(row0 + ai * 128 + m * 16) * 64 + wc * 32 + 8 * fq;
                    *(f32x4*)(rowp) = acc[ai][0][m][0]; *(f32x4*)(rowp + 4) = acc[ai][0][m][1]; }
        }
    }
};

struct StreamKOrder {
    int ntk, per, c;
    DEVI void init(int K, int G, int c_) { ntk = K / 64; per = (288 * ntk) / G; c = c_; }
    DEVI bool next(int i, pg8::Unit& u) const {
        const int s = c * per, e = s + per; int p0 = s;
        if (i >= 1) p0 = (s / ntk + 1) * ntk;
        if (i >= 2) p0 = (s / ntk + 2) * ntk;
        if (p0 >= e) return false;
        const int L = p0 / ntk, k = L / 9, r = L - 9 * k; int pend = (L + 1) * ntk; if (pend > e) pend = e;
        u.pn = k & 7; u.pm = r * 4 + (k >> 3); u.kt0 = p0 - L * ntk; u.nt = pend - p0; return true;
    }
    DEVI void a_ready(const pg8::Unit&) const {}
    DEVI void done(const pg8::Unit&) const {}
};
DEVI bool sk_has_pb(int pm, int pn) { const int k = (pm & 3) * 8 + pn, r = pm >> 2, L = r + 9 * k; return ((8 * L) % 9) >= 2; }
struct EpiSK {
    static constexpr bool PERM = true, AFTER_DRAIN = false;
    bf16_t* PA; bf16_t* PB;
    DEVI void operator()(const f32x4 (&acc)[2][2][4][2], const pg8::Unit& u, int wr, int wc, int fr, int fq) const {
        const int row0 = u.pm * 256 + wr * 64 + fr, col0 = u.pn * 256 + wc * 32 + 8 * fq;
        bf16_t* P = (u.kt0 == 0) ? PA : PB;
#pragma unroll
        for (int ai = 0; ai < 2; ++ai)
#pragma unroll
            for (int m = 0; m < 4; ++m) { bf16_t* rowp = P + (size_t)(row0 + ai * 128 + m * 16) * D + col0;
#pragma unroll
                for (int bj = 0; bj < 2; ++bj) { const f32x4 v0 = acc[ai][bj][m][0], v1 = acc[ai][bj][m][1];
                    u32x4 w; w.x = pk2(v0[0], v0[1]); w.y = pk2(v0[2], v0[3]); w.z = pk2(v1[0], v1[1]); w.w = pk2(v1[2], v1[3]);
                    *(u32x4*)(rowp + bj * 128) = w; } }
    }
};
DEVI void run_gemm_sk(unsigned char* lds, const bf16_t* A, const bf16_t* Bt, int K, bf16_t* PA, bf16_t* PB, int bid, int nb) {
    pg8::Gemm g; g.A = A; g.Bt = Bt; g.M = T; g.N = 2048; g.K = K;
    StreamKOrder S; S.init(K, nb, bid);
    EpiSK E; E.PA = PA; E.PB = PB;
    pg8::gemm_phase<EpiSK, StreamKOrder, false>((PG8_LAS unsigned char*)lds, g, S, E, nullptr);
}
template <class Epi> DEVI void run_gemm(unsigned char* lds, const bf16_t* A, const bf16_t* Bt, int N, int K, const Epi& E, int bid, int nb) {
    pg8::Gemm g; g.A = A; g.Bt = Bt; g.M = T; g.N = N; g.K = K;
    pg8::StaticOrder S; S.init(T, N, nb, bid, K);
    pg8::gemm_phase<Epi, pg8::StaticOrder, false>((PG8_LAS unsigned char*)lds, g, S, E, nullptr);
}

DEVI void transpose_load(const float* W, int N, int k0, int n0, int lane, f32x4 (&v)[16]) {
    const float* src = W + (size_t)(k0 + (lane >> 4)) * N + n0 + (lane & 15) * 4;
#pragma unroll
    for (int i = 0; i < 16; ++i) v[i] = *(const f32x4*)(src + (size_t)(4 * i) * N);
}
DEVI void transpose_store(const f32x4 (&v)[16], int K, bf16_t* WT, float* scr, int k0, int n0, int lane) {
#pragma unroll
    for (int i = 0; i < 16; ++i) { float* d = scr + (4 * i + (lane >> 4)) * 65 + (lane & 15) * 4; d[0] = v[i].x; d[1] = v[i].y; d[2] = v[i].z; d[3] = v[i].w; }
    WAVE_LDS_SYNC();
    const int c = lane & 7;
#pragma unroll
    for (int j = 0; j < 8; ++j) { const int n = (lane >> 3) + 8 * j; const float* s = scr + (8 * c) * 65 + n;
        u32x4 o; o.x = pk2(s[0 * 65], s[1 * 65]); o.y = pk2(s[2 * 65], s[3 * 65]); o.z = pk2(s[4 * 65], s[5 * 65]); o.w = pk2(s[6 * 65], s[7 * 65]);
        *(u32x4*)(WT + (size_t)(n0 + n) * K + k0 + 8 * c) = o; }
    WAVE_LDS_SYNC();
}
DEVI f32x4 ldpb4(const bf16_t* pb, int idx4) { const unsigned long long r = ((const unsigned long long*)pb)[idx4]; return (f32x4){__uint_as_float((unsigned)r << 16), __uint_as_float((unsigned)r & 0xffff0000u), __uint_as_float((unsigned)(r >> 32) << 16), __uint_as_float((unsigned)(r >> 32) & 0xffff0000u)}; }
template <int MODE> DEVI void rms_row_bf16(const float* xr, const float* w, bf16_t* o, int lane, float* xcopy = nullptr, const bf16_t* pa = nullptr, const bf16_t* pb = nullptr, int pm = 0) {
    f32x4 v[8], q[8], qa[8]; float s = 0.f;
#pragma unroll
    for (int j = 0; j < 8; ++j) { v[j] = ((const f32x4*)xr)[lane + 64 * j];
        if (MODE == 2) { qa[j] = ldpb4(pa, lane + 64 * j); if (sk_has_pb(pm, j)) q[j] = ldpb4(pb, lane + 64 * j); else q[j] = (f32x4){0.f, 0.f, 0.f, 0.f}; } }
    f32x4 ww[8];
#pragma unroll
    for (int j = 0; j < 8; ++j) ww[j] = ((const f32x4*)w)[lane + 64 * j];
#pragma unroll
    for (int j = 0; j < 8; ++j) { if (MODE == 2) v[j] = v[j] + (qa[j] + q[j]); s += (v[j].x * v[j].x + v[j].y * v[j].y) + (v[j].z * v[j].z + v[j].w * v[j].w); }
    const float r = rsqrtf(wave_sum(s) * (1.f / D) + EPS);
#pragma unroll
    for (int j = 0; j < 8; ++j) { if (MODE == 2) ((f32x4*)xcopy)[lane + 64 * j] = v[j];
        const unsigned lo = pk2(v[j].x * r * ww[j].x, v[j].y * r * ww[j].y), hi = pk2(v[j].z * r * ww[j].z, v[j].w * r * ww[j].w);
        ((unsigned long long*)o)[lane + 64 * j] = (unsigned long long)lo | ((unsigned long long)hi << 32); }
}
DEVI void rms_row_f32(const float* xr, const float* w, float* o, int lane, const bf16_t* pa, const bf16_t* pb, int pm) {
    f32x4 v[8], q[8], ww[8]; float s = 0.f;
#pragma unroll
    for (int j = 0; j < 8; ++j) { v[j] = ((const f32x4*)xr)[lane + 64 * j]; if (sk_has_pb(pm, j)) q[j] = ldpb4(pb, lane + 64 * j); else q[j] = (f32x4){0.f, 0.f, 0.f, 0.f}; ww[j] = ((const f32x4*)w)[lane + 64 * j]; }
#pragma unroll
    for (int j = 0; j < 8; ++j) { v[j] = v[j] + (q[j] + ldpb4(pa, lane + 64 * j)); s += (v[j].x * v[j].x + v[j].y * v[j].y) + (v[j].z * v[j].z + v[j].w * v[j].w); }
    const float r = rsqrtf(wave_sum(s) * (1.f / D) + EPS);
#pragma unroll
    for (int j = 0; j < 8; ++j) ((f32x4*)o)[lane + 64 * j] = (f32x4){v[j].x * r * ww[j].x, v[j].y * r * ww[j].y, v[j].z * r * ww[j].z, v[j].w * r * ww[j].w};
}
constexpr int CV_S0 = 8 * 48, CV_S1 = 8 * 16, CV_S2 = 8 * 64, CV_S3 = 32 * 16, CV_S4 = 8 * 97, CV_S5 = 16 * 16;
constexpr int CV_NST = CV_S0 + CV_S1 + CV_S2 + CV_S3 + CV_S4 + CV_S5 + CV_S2 + CV_S3;
constexpr int CV_G1 = 160 * 5, CV_G3 = 128 * 5, CV_P0_END = CV_NST - CV_G1 - CV_G3, CV_G1_END = CV_P0_END + CV_G1;
DEVI void convert_tiles(const Params& p, unsigned char* lds, int first, int stride, int end) {
    const int lane = otid() & 63, wave = otid() >> 6;
    float* scr = (float*)(lds + wave * 16640);
    unsigned char* ws = p.ws;
    const int kq = wave & 3, nq = wave >> 2;
    auto decode = [&](int st, const float*& W, bf16_t*& WT, int& K, int& N, int& k0, int& n0) -> bool {
        if (st >= end) return false;
        int r = st;
        if (r < CV_S0) { W = p.in[6]; WT = (bf16_t*)(ws + WS_WT_INA); K = 2048; N = 6144; }
        else if ((r -= CV_S0) < CV_S1) { W = p.in[8]; WT = (bf16_t*)(ws + WS_WT_OUTA); K = 2048; N = 2048; }
        else if ((r -= CV_S1) < CV_S2) { W = p.in[17]; WT = (bf16_t*)(ws + WS_WT_UP0); K = 2048; N = 8192; }
        else if ((r -= CV_S2) < CV_S3) { W = p.in[18]; WT = (bf16_t*)(ws + WS_WT_DN0); K = 8192; N = 2048; }
        else if ((r -= CV_S3) < CV_S4) { W = p.in[10]; WT = (bf16_t*)(ws + WS_WT_INB); K = 2048; N = NPROJ; }
        else if ((r -= CV_S4) < CV_S5) { W = p.in[15]; WT = (bf16_t*)(ws + WS_WT_OUTB); K = 4096; N = 2048; }
        else if ((r -= CV_S5) < CV_S2) { W = p.in[17] + (size_t)2048 * 8192; WT = (bf16_t*)(ws + WS_WT_UP1); K = 2048; N = 8192; }
        else { r -= CV_S2; W = p.in[18] + (size_t)8192 * 2048; WT = (bf16_t*)(ws + WS_WT_DN1); K = 8192; N = 2048; }
        const int nsb = (N + 127) / 128, KB = r / nsb, NB = r - KB * nsb;
        k0 = 256 * KB + 64 * kq; n0 = 128 * NB + 64 * nq;
        return n0 < N;
    };
    for (int st = first; st < end; st += 2 * stride) {
        const float *Wa = nullptr, *Wb = nullptr; bf16_t *WTa = nullptr, *WTb = nullptr; int Ka = 0, Na = 0, ka = 0, na = 0, Kb = 0, Nb = 0, kb = 0, nb2 = 0;
        const bool va = decode(st, Wa, WTa, Ka, Na, ka, na), vb = decode(st + stride, Wb, WTb, Kb, Nb, kb, nb2);
        f32x4 ta[16], tb[16];
        if (va) transpose_load(Wa, Na, ka, na, lane, ta);
        if (vb) transpose_load(Wb, Nb, kb, nb2, lane, tb);
        if (va) transpose_store(ta, Ka, WTa, scr, ka, na, lane);
        if (vb) transpose_store(tb, Kb, WTb, scr, kb, nb2, lane);
    }
}
DEVI void phase0(const Params& p, unsigned char* lds, int bid, int nb) {
    const int lane = otid() & 63, wave = otid() >> 6;
    const int gw = bid * 8 + wave, NGW = nb * 8;
    unsigned char* ws = p.ws;
    convert_tiles(p, lds, bid, nb, nb == 256 ? CV_P0_END : CV_NST);
    bf16_t* H = (bf16_t*)(ws + WS_H);
    for (int row = gw; row < T; row += NGW) {
        const float* src = row < TP ? p.in[0] + (size_t)row * D : p.in[1] + (size_t)(row - TP) * D;
        rms_row_bf16<0>(src, p.in[5], H + (size_t)row * D, lane);
    }
}
DEVI void rms2_load(const float* xr, const bf16_t* pa, const bf16_t* pb, int pm, int lane, f32x4 (&v)[8], unsigned long long (&ra)[8], unsigned long long (&rb)[8]) {
#pragma unroll
    for (int j = 0; j < 8; ++j) { v[j] = ((const f32x4*)xr)[lane + 64 * j]; ra[j] = ((const unsigned long long*)pa)[lane + 64 * j]; rb[j] = sk_has_pb(pm, j) ? ((const unsigned long long*)pb)[lane + 64 * j] : 0ull; }
}
DEVI f32x4 unpk4(unsigned long long r) { return (f32x4){__uint_as_float((unsigned)r << 16), __uint_as_float((unsigned)r & 0xffff0000u), __uint_as_float((unsigned)(r >> 32) << 16), __uint_as_float((unsigned)(r >> 32) & 0xffff0000u)}; }
DEVI void rms2_finish(f32x4 (&v)[8], const unsigned long long (&ra)[8], const unsigned long long (&rb)[8], const f32x4 (&ww)[8], float* xcopy, bf16_t* o, int lane) {
    float s = 0.f;
#pragma unroll
    for (int j = 0; j < 8; ++j) { v[j] = v[j] + (unpk4(ra[j]) + unpk4(rb[j])); s += (v[j].x * v[j].x + v[j].y * v[j].y) + (v[j].z * v[j].z + v[j].w * v[j].w); }
    const float r = rsqrtf(wave_sum(s) * (1.f / D) + EPS);
#pragma unroll
    for (int j = 0; j < 8; ++j) { ((f32x4*)xcopy)[lane + 64 * j] = v[j];
        const unsigned lo = pk2(v[j].x * r * ww[j].x, v[j].y * r * ww[j].y), hi = pk2(v[j].z * r * ww[j].z, v[j].w * r * ww[j].w);
        ((unsigned long long*)o)[lane + 64 * j] = (unsigned long long)lo | ((unsigned long long)hi << 32); }
}
DEVI void phase_rms(const Params& p, const float* w, int bid, int nb, bool first) {
    const int lane = otid() & 63, wave = otid() >> 6;
    float* X = (float*)(p.ws + WS_X); bf16_t* H = (bf16_t*)(p.ws + WS_H); const bf16_t* PA = (const bf16_t*)(p.ws + WS_PA); const bf16_t* PB = (const bf16_t*)(p.ws + WS_PB);
    f32x4 ww[8];
#pragma unroll
    for (int j = 0; j < 8; ++j) ww[j] = ((const f32x4*)w)[lane + 64 * j];
    const int NGW = nb * 8;
    for (int row = bid * 8 + wave; row < T; row += 2 * NGW) {
        const int row2 = row + NGW; const bool has2 = row2 < T;
        const float* srcA = first ? (row < TP ? p.in[0] + (size_t)row * D : p.in[1] + (size_t)(row - TP) * D) : X + (size_t)row * D;
        f32x4 va[8], vb[8]; unsigned long long aa[8], ab[8], ba[8], bb[8];
        rms2_load(srcA, PA + (size_t)row * D, PB + (size_t)row * D, row >> 8, lane, va, aa, ab);
        if (has2) { const float* srcB = first ? (row2 < TP ? p.in[0] + (size_t)row2 * D : p.in[1] + (size_t)(row2 - TP) * D) : X + (size_t)row2 * D;
            rms2_load(srcB, PA + (size_t)row2 * D, PB + (size_t)row2 * D, row2 >> 8, lane, vb, ba, bb); }
        rms2_finish(va, aa, ab, ww, X + (size_t)row * D, H + (size_t)row * D, lane);
        if (has2) rms2_finish(vb, ba, bb, ww, X + (size_t)row2 * D, H + (size_t)row2 * D, lane);
    }
}
DEVI void rms2_finish_f32(f32x4 (&v)[8], const unsigned long long (&ra)[8], const unsigned long long (&rb)[8], const f32x4 (&ww)[8], float* o, int lane) {
    float s = 0.f;
#pragma unroll
    for (int j = 0; j < 8; ++j) { v[j] = v[j] + (unpk4(ra[j]) + unpk4(rb[j])); s += (v[j].x * v[j].x + v[j].y * v[j].y) + (v[j].z * v[j].z + v[j].w * v[j].w); }
    const float r = rsqrtf(wave_sum(s) * (1.f / D) + EPS);
#pragma unroll
    for (int j = 0; j < 8; ++j) ((f32x4*)o)[lane + 64 * j] = (f32x4){v[j].x * r * ww[j].x, v[j].y * r * ww[j].y, v[j].z * r * ww[j].z, v[j].w * r * ww[j].w};
}
DEVI void phase_rms_final(const Params& p, int bid, int nb) {
    const int lane = otid() & 63, wave = otid() >> 6;
    const float* X = (const float*)(p.ws + WS_X); const bf16_t* PA = (const bf16_t*)(p.ws + WS_PA); const bf16_t* PB = (const bf16_t*)(p.ws + WS_PB);
    f32x4 ww[8];
#pragma unroll
    for (int j = 0; j < 8; ++j) ww[j] = ((const f32x4*)p.in[19])[lane + 64 * j];
    const int NGW = nb * 8;
    for (int row = bid * 8 + wave; row < T; row += 2 * NGW) {
        const int row2 = row + NGW; const bool has2 = row2 < T;
        f32x4 va[8], vb[8]; unsigned long long aa[8], ab[8], ba[8], bb[8];
        rms2_load(X + (size_t)row * D, PA + (size_t)row * D, PB + (size_t)row * D, row >> 8, lane, va, aa, ab);
        if (has2) rms2_load(X + (size_t)row2 * D, PA + (size_t)row2 * D, PB + (size_t)row2 * D, row2 >> 8, lane, vb, ba, bb);
        rms2_finish_f32(va, aa, ab, ww, p.out + O_YP + (size_t)row * D, lane);
        if (has2) rms2_finish_f32(vb, ba, bb, ww, p.out + O_YP + (size_t)row2 * D, lane);
    }
}

DEVI void phase_conv_a(const Params& p, int bid, int nb) {
    const bf16_t* P1 = (const bf16_t*)(p.ws + WS_ACT); bf16_t* GBp = (bf16_t*)(p.ws + WS_GB);
    const float* wcv = p.in[7]; const float* st = p.in[2];
    const int idx0 = bid * 512 + otid(), NT = nb * 512, c0 = (idx0 & 255) * 8;
    float w0[8], w1[8], w2[8]; ld8f(wcv + c0, w0); ld8f(wcv + 2048 + c0, w1); ld8f(wcv + 4096 + c0, w2);
    auto geom = [&](int idx, int& t, bool& smp, int& b, int& pos, int& L) { t = idx >> 8; smp = t >= TP; if (!smp) { b = t >> 11; pos = t & 2047; L = 2048; } else { const int s = t - TP; b = s >> 3; pos = s & 7; L = 8; } };
    auto load = [&](int idx, u32x4 (&r0)[3], u32x4 (&r1)[2], u32x4 (&r2)[2]) {
        int t, b, pos, L; bool smp; geom(idx, t, smp, b, pos, L);
        const bf16_t* row = P1 + (size_t)t * 6144 + c0;
        r0[0] = *(const u32x4*)(row); r0[1] = *(const u32x4*)(row + 2048); r0[2] = *(const u32x4*)(row + 4096);
        if (pos >= 1) { r1[0] = *(const u32x4*)(row - 6144 + 2048); r1[1] = *(const u32x4*)(row - 6144 + 4096); }
        else if (smp) { const float* s1 = st + (size_t)(b * 2 + 1) * 2048 + c0; r1[0] = *(const u32x4*)(s1); r1[1] = *(const u32x4*)(s1 + 4); }
        else { r1[0] = (u32x4){0u, 0u, 0u, 0u}; r1[1] = r1[0]; }
        if (pos >= 2) { r2[0] = *(const u32x4*)(row - 2 * 6144 + 2048); r2[1] = *(const u32x4*)(row - 2 * 6144 + 4096); }
        else if (smp) { const float* s2 = st + (size_t)(b * 2 + pos) * 2048 + c0; r2[0] = *(const u32x4*)(s2); r2[1] = *(const u32x4*)(s2 + 4); }
        else { r2[0] = (u32x4){0u, 0u, 0u, 0u}; r2[1] = r2[0]; }
    };
    auto decode = [&](const u32x4 (&r)[2], bool from_rows, float (&u)[8]) {
        if (from_rows) { float cc[8], xx[8]; unpack8(r[0], cc); unpack8(r[1], xx);
#pragma unroll
            for (int i = 0; i < 8; ++i) u[i] = cc[i] * xx[i]; }
        else { u[0] = __uint_as_float(r[0].x); u[1] = __uint_as_float(r[0].y); u[2] = __uint_as_float(r[0].z); u[3] = __uint_as_float(r[0].w);
               u[4] = __uint_as_float(r[1].x); u[5] = __uint_as_float(r[1].y); u[6] = __uint_as_float(r[1].z); u[7] = __uint_as_float(r[1].w); }
    };
    auto finish = [&](int idx, const u32x4 (&r0)[3], const u32x4 (&r1)[2], const u32x4 (&r2)[2]) {
        int t, b, pos, L; bool smp; geom(idx, t, smp, b, pos, L);
        float gb[8], u0[8], u1[8], u2[8];
        unpack8(r0[0], gb); { const u32x4 cx[2] = {r0[1], r0[2]}; decode(cx, true, u0); }
        decode(r1, pos >= 1, u1); decode(r2, pos >= 2, u2);
        float g[8];
#pragma unroll
        for (int i = 0; i < 8; ++i) g[i] = gb[i] * (w0[i] * u2[i] + w1[i] * u1[i] + w2[i] * u0[i]);
        *(u32x4*)(GBp + (size_t)t * 2048 + c0) = pack8(g);
        if (pos >= L - 2) { float* o = p.out + (smp ? O_CAS : O_CAP) + (size_t)(b * 2 + (pos - (L - 2))) * 2048 + c0; st8f(o, u0); }
    };
    for (int idx = idx0; idx < T * 256; idx += 2 * NT) {
        const int idxB = idx + NT; const bool hasB = idxB < T * 256;
        u32x4 a0[3], a1[2], a2[2], b0[3], b1[2], b2[2];
        load(idx, a0, a1, a2);
        if (hasB) load(idxB, b0, b1, b2);
        finish(idx, a0, a1, a2);
        if (hasB) finish(idxB, b0, b1, b2);
    }
}

DEVI void phase_g1(const Params& p, int bid, int nb) {
    unsigned char* ws = p.ws;
    const bf16_t* QKV = (const bf16_t*)(ws + WS_QKV);
    bf16_t* QN = (bf16_t*)(ws + WS_QN); bf16_t* KN = (bf16_t*)(ws + WS_KN); bf16_t* VS = (bf16_t*)(ws + WS_VS);
    bf16_t* KT = (bf16_t*)(ws + WS_KT); bf16_t* VT = (bf16_t*)(ws + WS_VT);
    const float* wcv = p.in[11]; const float* st = p.in[3];
    const int g1lane = otid() & 63, g1wave = otid() >> 6;
    const int ch0 = ((bid * 8 + g1wave) & 63) * 128 + (g1lane >> 2) * 8;
    float w0[8], w1[8], w2[8], w3[8]; ld8f(wcv + ch0, w0); ld8f(wcv + 8192 + ch0, w1); ld8f(wcv + 2 * 8192 + ch0, w2); ld8f(wcv + 3 * 8192 + ch0, w3);
    for (int wi = bid * 8 + g1wave; wi < (T / 32) * 64; wi += nb * 8) {
        const int t0 = (wi >> 6) * 32 + (g1lane & 3) * 8;
        const bool smp = t0 >= TP; int b, pos0;
        if (!smp) { b = t0 >> 11; pos0 = t0 & 2047; } else { b = (t0 - TP) >> 3; pos0 = 0; }
        float h0[8], h1[8], h2[8];
        if (pos0 > 0) { const bf16_t* r = QKV + (size_t)t0 * 8192 + ch0; unpack8(*(const u32x4*)(r - 3 * 8192), h0); unpack8(*(const u32x4*)(r - 2 * 8192), h1); unpack8(*(const u32x4*)(r - 8192), h2); }
        else if (smp) { const float* r = st + (size_t)b * 3 * 8192 + ch0; ld8f(r, h0); ld8f(r + 8192, h1); ld8f(r + 2 * 8192, h2); }
        else {
#pragma unroll
            for (int i = 0; i < 8; ++i) { h0[i] = 0.f; h1[i] = 0.f; h2[i] = 0.f; } }
        float y[8][8];
        const bool tailp = (!smp) && (pos0 == 2040);
        u32x4 xraw[8];
#pragma unroll
        for (int i = 0; i < 8; ++i) xraw[i] = *(const u32x4*)(QKV + (size_t)(t0 + i) * 8192 + ch0);
#pragma unroll
        for (int i = 0; i < 8; ++i) {
            float x[8]; unpack8(xraw[i], x);
#pragma unroll
            for (int c = 0; c < 8; ++c) { const float a = w0[c] * h0[c] + w1[c] * h1[c] + w2[c] * h2[c] + w3[c] * x[c]; y[i][c] = silu_f(a); h0[c] = h1[c]; h1[c] = h2[c]; h2[c] = x[c]; }
            if (i >= 5 && (smp || tailp)) { float* o = p.out + (smp ? O_CBS : O_CBP) + (size_t)(b * 3 + (i - 5)) * 8192 + ch0; st8f(o, x); }
        }
        if (ch0 < 4096) {
            const float sc = ch0 < 2048 ? 0.08838834764831845f : 1.f;
#pragma unroll
            for (int i = 0; i < 8; ++i) { float s = 0.f;
#pragma unroll
                for (int c = 0; c < 8; ++c) s += y[i][c] * y[i][c];
                s += __shfl_xor(s, 4); s += __shfl_xor(s, 8); s += __shfl_xor(s, 16); s += __shfl_xor(s, 32);
                const float r = rsqrtf(s + EPS) * sc;
#pragma unroll
                for (int c = 0; c < 8; ++c) y[i][c] *= r; }
        }
        if (ch0 < 2048) {
#pragma unroll
            for (int i = 0; i < 8; ++i) *(u32x4*)(QN + (size_t)(t0 + i) * 2048 + ch0) = pack8(y[i]);
        } else if (ch0 < 4096) {
            const int ck = ch0 - 2048;
#pragma unroll
            for (int i = 0; i < 8; ++i) *(u32x4*)(KN + (size_t)(t0 + i) * 2048 + ck) = pack8(y[i]);
            if (!smp) { const int n = pos0 >> 6, j0 = pos0 & 63, hk = ck >> 7, d0 = ck & 127;
                bf16_t* base = KT + ((size_t)((b * 32 + n) * 16 + hk) * 128 + d0) * 64 + j0;
#pragma unroll
                for (int c = 0; c < 8; ++c) { u32x4 w; w.x = pk2(y[0][c], y[1][c]); w.y = pk2(y[2][c], y[3][c]); w.z = pk2(y[4][c], y[5][c]); w.w = pk2(y[6][c], y[7][c]); *(u32x4*)(base + c * 64) = w; } }
        } else {
            const int cv = ch0 - 4096;
            if (smp) {
#pragma unroll
                for (int i = 0; i < 8; ++i) *(u32x4*)(VS + (size_t)(t0 - TP + i) * 4096 + cv) = pack8(y[i]);
            } else { const int n = pos0 >> 6, j0 = pos0 & 63, hv = cv >> 7, e0 = cv & 127;
                bf16_t* base = VT + ((size_t)((b * 32 + n) * 32 + hv) * 128 + e0) * 64 + j0;
#pragma unroll
                for (int c = 0; c < 8; ++c) { u32x4 w; w.x = pk2(y[0][c], y[1][c]); w.y = pk2(y[2][c], y[3][c]); w.z = pk2(y[4][c], y[5][c]); w.w = pk2(y[6][c], y[7][c]); *(u32x4*)(base + c * 64) = w; } }
        }
    }
    const float* BA = (const float*)(ws + WS_BA); float* BETA = (float*)(ws + WS_BETA); float* GG = (float*)(ws + WS_GG);
    for (int idx = bid * 512 + otid(); idx < T * 32; idx += nb * 512) {
        const int t = idx >> 5, h = idx & 31;
        const float br = BA[(size_t)t * 64 + h], ar = BA[(size_t)t * 64 + 32 + h];
        BETA[idx] = 1.f / (1.f + expf(-br));
        const float xs = ar + p.in[13][h];
        const float sp = fmaxf(xs, 0.f) + log1pf(expf(-fabsf(xs)));
        GG[idx] = -expf(p.in[12][h]) * sp;
    }
}

DEVI void phase_g2(const Params& p, unsigned char* lds, int bid, int nb) {
    unsigned char* ws = p.ws;
    const int lane0 = otid() & 63, wave = otid() >> 6;
    float* Am = (float*)(lds + wave * 16384);
    const bf16_t* QN = (const bf16_t*)(ws + WS_QN); const bf16_t* KN = (const bf16_t*)(ws + WS_KN);
    const bf16_t* KT = (const bf16_t*)(ws + WS_KT); const bf16_t* VT = (const bf16_t*)(ws + WS_VT);
    const float* BETA = (const float*)(ws + WS_BETA); const float* GG = (const float*)(ws + WS_GG); float* GC = (float*)(ws + WS_GC);
    bf16_t* UT = (bf16_t*)(ws + WS_UT); bf16_t* WW = (bf16_t*)(ws + WS_WW); bf16_t* QKM = (bf16_t*)(ws + WS_QKM);
    for (int it = bid * 8 + wave; it < 4096; it += nb * 8) {
        int lane = lane0; asm volatile("" : "+v"(lane));
        const int fr = lane & 15, fq = lane >> 4;
        const int b = it >> 10, n = (it >> 5) & 31, h = it & 31, hk = h >> 1, t0 = b * 2048 + n * 64;
        const size_t itemK = (size_t)((b * 32 + n) * 16 + hk);
        float gc = GG[(size_t)(t0 + lane) * 32 + h]; const float bt = BETA[(size_t)(t0 + lane) * 32 + h];
#pragma unroll
        for (int o = 1; o < 64; o <<= 1) { const float v = __shfl_up(gc, o); if (lane >= o) gc += v; }
        GC[(size_t)(t0 + lane) * 32 + h] = gc;
        const bf16_t* kbase = KN + (size_t)(t0 + fr) * 2048 + hk * 128 + 8 * fq;
        const bf16_t* qbase = QN + (size_t)(t0 + fr) * 2048 + hk * 128 + 8 * fq;
        {
            bf16x8 kf[4][4], qf[2][4];
#pragma unroll
            for (int m = 0; m < 4; ++m)
#pragma unroll
                for (int kk = 0; kk < 4; ++kk) kf[m][kk] = ldfrag(kbase + (size_t)(16 * m) * 2048 + 32 * kk);
#pragma unroll
            for (int m = 0; m < 4; ++m)
#pragma unroll
                for (int nn = 0; nn < 4; ++nn) {
                    f32x4 acc = {0.f, 0.f, 0.f, 0.f};
                    if (nn <= m) {
#pragma unroll
                        for (int kk = 0; kk < 4; ++kk) acc = mfma16(kf[m][kk], kf[nn][kk], acc); }
                    const int j = 16 * nn + fr; const float gj = __shfl(gc, j);
#pragma unroll
                    for (int jj = 0; jj < 4; ++jj) { const int i = 16 * m + 4 * fq + jj; const float gi = __shfl(gc, i), bi = __shfl(bt, i);
                        Am[i * 64 + j] = (i > j) ? -(bi * acc[jj] * __expf(gi - gj)) : 0.f; }
                }
            bf16_t* qkb = QKM + (size_t)it * 4096;
#pragma unroll
            for (int ni = 0; ni < 4; ++ni) { const int i = 16 * ni + fr; const float gi = __shfl(gc, i);
                if ((ni & 1) == 0) {
#pragma unroll
                    for (int m = 0; m < 2; ++m)
#pragma unroll
                        for (int kk = 0; kk < 4; ++kk) qf[m][kk] = ldfrag(qbase + (size_t)(16 * (ni + m)) * 2048 + 32 * kk); }
#pragma unroll
                for (int mj = 0; mj < 4; ++mj) {
                    f32x4 acc = {0.f, 0.f, 0.f, 0.f};
                    if (ni >= mj) {
#pragma unroll
                        for (int kk = 0; kk < 4; ++kk) acc = mfma16(kf[mj][kk], qf[ni & 1][kk], acc); }
                    float o[4];
#pragma unroll
                    for (int jj = 0; jj < 4; ++jj) { const int j = 16 * mj + 4 * fq + jj; const float gj = __shfl(gc, j); o[jj] = (i >= j) ? acc[jj] * __expf(gi - gj) : 0.f; }
                    *(unsigned long long*)(qkb + (size_t)i * 64 + 16 * mj + 4 * fq) = (unsigned long long)pk2(o[0], o[1]) | ((unsigned long long)pk2(o[2], o[3]) << 32);
                } }
        }
        WAVE_LDS_SYNC();
        bf16x8 vfr[8][2];
        { const bf16_t* vtb = VT + (size_t)it * 8192 + (size_t)fr * 64 + 8 * fq;
#pragma unroll
          for (int t8 = 0; t8 < 8; ++t8) { vfr[t8][0] = ldfrag(vtb + t8 * 1024); vfr[t8][1] = ldfrag(vtb + t8 * 1024 + 32); } }
        {
            float a[64];
#pragma unroll
            for (int i = 0; i < 64; ++i) a[i] = Am[i * 64 + lane];
            typedef float f32x2_t __attribute__((ext_vector_type(2)));
#pragma unroll
            for (int i = 2; i < 64; ++i) {
                const int rb = __float_as_int(a[i]); f32x2_t acc = {a[i], 0.f};
#pragma unroll
                for (int j = 1; j + 1 < i; j += 2) { const f32x2_t s = {__int_as_float(__builtin_amdgcn_readlane(rb, j)), __int_as_float(__builtin_amdgcn_readlane(rb, j + 1))};
                    const f32x2_t av = {a[j], a[j + 1]}; acc = __builtin_elementwise_fma(s, av, acc); }
                float r = acc.x + acc.y;
                if (((i - 1) & 1) != 0) r += __int_as_float(__builtin_amdgcn_readlane(rb, i - 1)) * a[i - 1];
                a[i] = r;
            }
#pragma unroll
            for (int i = 2; i < 64; ++i) Am[i * 64 + lane] = a[i];
        }
        WAVE_LDS_SYNC();
        {
            bf16x8 tp[4][2], tpp[4][2];
#pragma unroll
            for (int kk = 0; kk < 2; ++kk) {
                float bj[8], bg[8];
#pragma unroll
                for (int s = 0; s < 8; ++s) { const int j = 32 * kk + 8 * fq + s; bj[s] = __shfl(bt, j); bg[s] = bj[s] * __expf(__shfl(gc, j)); }
#pragma unroll
                for (int mi = 0; mi < 4; ++mi) { const int i = 16 * mi + fr; float tv[8]; ld8f(Am + i * 64 + 32 * kk + 8 * fq, tv);
                    float a[8], c[8];
#pragma unroll
                    for (int s = 0; s < 8; ++s) { const float t = tv[s] + ((i == 32 * kk + 8 * fq + s) ? 1.f : 0.f); a[s] = t * bj[s]; c[s] = t * bg[s]; }
                    const u32x4 pa = pack8(a), pc = pack8(c); tp[mi][kk] = __builtin_bit_cast(bf16x8, pa); tpp[mi][kk] = __builtin_bit_cast(bf16x8, pc); }
            }
            bf16_t* utb = UT + (size_t)it * 8192; bf16_t* stg = (bf16_t*)Am;
            WAVE_LDS_SYNC();
#pragma unroll
            for (int ne = 0; ne < 8; ++ne) {
#pragma unroll
                for (int mi = 0; mi < 4; ++mi) { f32x4 acc = {0.f, 0.f, 0.f, 0.f}; acc = mfma16(tp[mi][0], vfr[ne][0], acc); acc = mfma16(tp[mi][1], vfr[ne][1], acc);
                    *(unsigned long long*)(stg + (16 * ne + fr) * 64 + 16 * mi + 4 * fq) = (unsigned long long)pk2(acc[0], acc[1]) | ((unsigned long long)pk2(acc[2], acc[3]) << 32); } }
            WAVE_LDS_SYNC();
            { u32x4 tv[16];
#pragma unroll
              for (int q = 0; q < 16; ++q) tv[q] = *(const u32x4*)(stg + q * 512 + lane * 8);
#pragma unroll
              for (int q = 0; q < 16; ++q) *(u32x4*)(utb + q * 512 + lane * 8) = tv[q]; }
            WAVE_LDS_SYNC();
            bf16x8 kfr[8][2];
            { const bf16_t* ktb = KT + itemK * 8192 + (size_t)fr * 64 + 8 * fq;
#pragma unroll
              for (int t8 = 0; t8 < 8; ++t8) { kfr[t8][0] = ldfrag(ktb + t8 * 1024); kfr[t8][1] = ldfrag(ktb + t8 * 1024 + 32); } }
            bf16_t* wwb = WW + (size_t)it * 8192;
#pragma unroll
            for (int md = 0; md < 8; ++md) {
#pragma unroll
                for (int ni = 0; ni < 4; ++ni) { f32x4 acc = {0.f, 0.f, 0.f, 0.f}; acc = mfma16(kfr[md][0], tpp[ni][0], acc); acc = mfma16(kfr[md][1], tpp[ni][1], acc);
                    *(unsigned long long*)(stg + (16 * ni + fr) * 128 + 16 * md + 4 * fq) = (unsigned long long)pk2(acc[0], acc[1]) | ((unsigned long long)pk2(acc[2], acc[3]) << 32); } }
            WAVE_LDS_SYNC();
            { u32x4 tv[16];
#pragma unroll
              for (int q = 0; q < 16; ++q) tv[q] = *(const u32x4*)(stg + q * 512 + lane * 8);
#pragma unroll
              for (int q = 0; q < 16; ++q) *(u32x4*)(wwb + q * 512 + lane * 8) = tv[q]; }
        }
        WAVE_LDS_SYNC();
    }
}

template <bool DIAG> DEVI void g3_chain(const Params& p, unsigned char* lds, int item_bh) {
    unsigned char* ws = p.ws;
    const int tid = otid(), lane = tid & 63, w = tid >> 6, fr = lane & 15, fq = lane >> 4;
    const int b = item_bh >> 5, h = item_bh & 31, hk = h >> 1, m = w & 3, eh = w >> 2;
    bf16_t* St = (bf16_t*)lds; bf16_t* VNT = (bf16_t*)(lds + 34816); bf16_t* VNS = (bf16_t*)(lds + 34816 + 18432); float* RED = (float*)(lds + 34816 + 2 * 18432);
    const bf16_t* QN = (const bf16_t*)(ws + WS_QN); const bf16_t* KT = (const bf16_t*)(ws + WS_KT);
    const bf16_t* UT = (const bf16_t*)(ws + WS_UT); const bf16_t* WW = (const bf16_t*)(ws + WS_WW); const bf16_t* QKM = (const bf16_t*)(ws + WS_QKM);
    const float* GC = (const float*)(ws + WS_GC); const bf16_t* Z = (const bf16_t*)(ws + WS_Z); bf16_t* OG = (bf16_t*)(ws + WS_OG);
    const float* onorm = p.in[14];
    f32x4 s[2][4];
#pragma unroll
    for (int a = 0; a < 2; ++a)
#pragma unroll
        for (int c = 0; c < 4; ++c) { s[a][c] = (f32x4){0.f, 0.f, 0.f, 0.f};
            *(unsigned long long*)(St + (size_t)(16 * (4 * eh + c) + fr) * 136 + 16 * (2 * m + a) + 4 * fq) = 0ull; }
    LDS_BARRIER();
    float on[4];
#pragma unroll
    for (int ne = 0; ne < 4; ++ne) on[ne] = onorm[16 * (4 * eh + ne) + fr];
    bf16x8 wf[4], qf[4], qkf[2], ktf[2][2]; float gi[4], gl;
    bf16x8 nwf[4], nqf[4], nqkf[2], nktf[2][2]; float ngi[4], ngl;
    PG8_LAS unsigned char* dma = (PG8_LAS unsigned char*)lds + 73728 + w * 8192;
#define CHAIN_LOAD_A(WF, QF, QKF, KTF, GI, GL, n_) do { \
        const size_t item_ = (size_t)((b * 32 + (n_)) * 32 + h), itemK_ = (size_t)((b * 32 + (n_)) * 16 + hk); const int t0_ = b * 2048 + (n_) * 64; \
        _Pragma("unroll") for (int k2 = 0; k2 < 2; ++k2) { QKF[k2] = ldfrag(QKM + item_ * 4096 + (size_t)(16 * m + fr) * 64 + 32 * k2 + 8 * fq); \
            _Pragma("unroll") for (int a = 0; a < 2; ++a) KTF[a][k2] = ldfrag(KT + itemK_ * 8192 + (size_t)(16 * (2 * m + a) + fr) * 64 + 32 * k2 + 8 * fq); } \
        _Pragma("unroll") for (int kk = 0; kk < 4; ++kk) { WF[kk] = ldfrag(WW + item_ * 8192 + (size_t)(16 * m + fr) * 128 + 32 * kk + 8 * fq); QF[kk] = ldfrag(QN + (size_t)(t0_ + 16 * m + fr) * 2048 + hk * 128 + 32 * kk + 8 * fq); } \
        _Pragma("unroll") for (int jj = 0; jj < 4; ++jj) GI[jj] = GC[(size_t)(t0_ + 16 * m + 4 * fq + jj) * 32 + h]; \
        GL = GC[(size_t)(t0_ + 63) * 32 + h]; } while (0)
#define CHAIN_DMA(n_, buf_) do { \
        const size_t item_ = (size_t)((b * 32 + (n_)) * 32 + h); const int t0_ = b * 2048 + (n_) * 64; \
        _Pragma("unroll") for (int q = 0; q < 2; ++q) { const int pi = q * 64 + lane; \
            __builtin_amdgcn_global_load_lds((const unsigned*)(UT + item_ * 8192 + (size_t)(64 * eh + (pi >> 1)) * 64 + 16 * m + 8 * (pi & 1)), (PG8_LAS unsigned*)(dma + (buf_) * 4096 + q * 1024), 16, 0, 0); \
            __builtin_amdgcn_global_load_lds((const unsigned*)(Z + (size_t)(t0_ + 16 * m + (pi >> 3)) * 4096 + h * 128 + 64 * eh + 8 * (pi & 7)), (PG8_LAS unsigned*)(dma + (buf_) * 4096 + 2048 + q * 1024), 16, 0, 0); } \
        asm volatile("" ::: "memory"); } while (0)
    if constexpr (!DIAG) CHAIN_DMA(0, 0);
    CHAIN_LOAD_A(wf, qf, qkf, ktf, gi, gl, 0);
    auto chain_body = [&](const int n, auto FIRST_, auto LAST_) {
        constexpr bool FIRST = decltype(FIRST_)::value, LAST = decltype(LAST_)::value;
        const int t0 = b * 2048 + n * 64;
        f32x4 P[4], O1[4];
#pragma unroll
        for (int ne = 0; ne < 4; ++ne) { P[ne] = (f32x4){0.f, 0.f, 0.f, 0.f}; O1[ne] = (f32x4){0.f, 0.f, 0.f, 0.f};
#pragma unroll
            for (int kk = 0; kk < 4; ++kk) { const bf16x8 bf = ldfrag(St + (size_t)(16 * (4 * eh + ne) + fr) * 136 + 32 * kk + 8 * fq); P[ne] = mfma16(wf[kk], bf, P[ne]); O1[ne] = mfma16(qf[kk], bf, O1[ne]); } }
        if constexpr (!LAST && !DIAG) CHAIN_DMA(n + 1, (n + 1) & 1);
        if constexpr (!LAST && !DIAG) CHAIN_LOAD_A(nwf, nqf, nqkf, nktf, ngi, ngl, n + 1);
        unsigned long long ut[4];
#pragma unroll
        for (int ne = 0; ne < 4; ++ne) ut[ne] = *(const PG8_LAS unsigned long long*)(dma + (n & 1) * 4096 + ((16 * ne + fr) * 2 + (fq >> 1)) * 16 + (fq & 1) * 8);
        float eg[4], ed[4];
#pragma unroll
        for (int jj = 0; jj < 4; ++jj) { eg[jj] = __expf(gi[jj]); ed[jj] = __expf(gl - gi[jj]); }
#pragma unroll
        for (int ne = 0; ne < 4; ++ne) { float vn[4];
            vn[0] = bf2f((unsigned short)(ut[ne] & 0xffffu)) - P[ne][0]; vn[1] = bf2f((unsigned short)((ut[ne] >> 16) & 0xffffu)) - P[ne][1];
            vn[2] = bf2f((unsigned short)((ut[ne] >> 32) & 0xffffu)) - P[ne][2]; vn[3] = bf2f((unsigned short)((ut[ne] >> 48) & 0xffffu)) - P[ne][3];
            const size_t off = (size_t)(16 * (4 * eh + ne) + fr) * 72 + 16 * m + 4 * fq;
            *(unsigned long long*)(VNT + off) = (unsigned long long)pk2(vn[0], vn[1]) | ((unsigned long long)pk2(vn[2], vn[3]) << 32);
            *(unsigned long long*)(VNS + off) = (unsigned long long)pk2(vn[0] * ed[0], vn[1] * ed[1]) | ((unsigned long long)pk2(vn[2] * ed[2], vn[3] * ed[3]) << 32);
#pragma unroll
            for (int jj = 0; jj < 4; ++jj) O1[ne][jj] *= eg[jj]; }
        LDS_BARRIER();
#pragma unroll
        for (int ne = 0; ne < 4; ++ne)
#pragma unroll
            for (int k2 = 0; k2 < 2; ++k2) { const bf16x8 bf = ldfrag(VNT + (size_t)(16 * (4 * eh + ne) + fr) * 72 + 32 * k2 + 8 * fq); O1[ne] = mfma16(qkf[k2], bf, O1[ne]); }
        float ss[4];
#pragma unroll
        for (int jj = 0; jj < 4; ++jj) { float v = O1[0][jj] * O1[0][jj] + O1[1][jj] * O1[1][jj] + O1[2][jj] * O1[2][jj] + O1[3][jj] * O1[3][jj];
            v += __shfl_xor(v, 1); v += __shfl_xor(v, 2); v += __shfl_xor(v, 4); v += __shfl_xor(v, 8); ss[jj] = v; }
        if (fr == 0) {
#pragma unroll
            for (int jj = 0; jj < 4; ++jj) RED[eh * 64 + 16 * m + 4 * fq + jj] = ss[jj]; }
        const float egl = __expf(gl);
#pragma unroll
        for (int a = 0; a < 2; ++a)
#pragma unroll
            for (int ne = 0; ne < 4; ++ne) { s[a][ne] = s[a][ne] * egl;
#pragma unroll
                for (int k2 = 0; k2 < 2; ++k2) { const bf16x8 bf = ldfrag(VNS + (size_t)(16 * (4 * eh + ne) + fr) * 72 + 32 * k2 + 8 * fq); s[a][ne] = mfma16(ktf[a][k2], bf, s[a][ne]); } }
        LDS_BARRIER();
#pragma unroll
        for (int a = 0; a < 2; ++a)
#pragma unroll
            for (int ne = 0; ne < 4; ++ne)
                *(unsigned long long*)(St + (size_t)(16 * (4 * eh + ne) + fr) * 136 + 16 * (2 * m + a) + 4 * fq) = (unsigned long long)pk2(s[a][ne][0], s[a][ne][1]) | ((unsigned long long)pk2(s[a][ne][2], s[a][ne][3]) << 32);
#pragma unroll
        for (int jj = 0; jj < 4; ++jj) { const int i = 16 * m + 4 * fq + jj; const float r = rsqrtf((RED[i] + RED[64 + i]) * (1.f / 128.f) + EPS);
            const size_t ro = (size_t)(t0 + i) * 4096 + h * 128;
#pragma unroll
            for (int ne = 0; ne < 4; ++ne) { const int e = 16 * (4 * eh + ne) + fr; const float z = bf2f(*(const PG8_LAS unsigned short*)(dma + (n & 1) * 4096 + 2048 + ((4 * fq + jj) * 8 + 2 * ne + (fr >> 3)) * 16 + (fr & 7) * 2));
                const unsigned short ov = f2bf(O1[ne][jj] * r * on[ne] * silu_f(z)); if constexpr (!DIAG) OG[ro + e] = ov; else asm volatile("" :: "v"((unsigned)ov)); } }
#pragma unroll
        for (int kk = 0; kk < 4; ++kk) { if constexpr (!DIAG) { wf[kk] = nwf[kk]; qf[kk] = nqf[kk]; gi[kk] = ngi[kk]; } }
        if constexpr (!DIAG) { gl = ngl; qkf[0] = nqkf[0]; qkf[1] = nqkf[1]; ktf[0][0] = nktf[0][0]; ktf[0][1] = nktf[0][1]; ktf[1][0] = nktf[1][0]; ktf[1][1] = nktf[1][1]; }
        LDS_BARRIER();
    };
    chain_body(0, std::true_type{}, std::false_type{});
#pragma unroll 1
    for (int n = 1; n < 31; ++n) chain_body(n, std::false_type{}, std::false_type{});
    chain_body(31, std::false_type{}, std::true_type{});
#undef CHAIN_LOAD_A
#undef CHAIN_DMA
    if constexpr (DIAG) { asm volatile("" :: "v"(s[0][0][0]), "v"(s[1][3][3])); return; }
    float* so = p.out + O_SSP + (size_t)item_bh * 16384;
#pragma unroll
    for (int a = 0; a < 2; ++a)
#pragma unroll
        for (int ne = 0; ne < 4; ++ne)
#pragma unroll
            for (int jj = 0; jj < 4; ++jj) so[(size_t)(16 * (2 * m + a) + 4 * fq + jj) * 128 + 16 * (4 * eh + ne) + fr] = s[a][ne][jj];
}

template <bool DIAG> DEVI void g3_sample(const Params& p, unsigned char* lds, int first, int stride, int end) {
    unsigned char* ws = p.ws;
    const int tid0 = otid();
    bf16_t* St = (bf16_t*)lds;
    float* KF = (float*)(lds + 34816); float* QF = KF + 1024; float* VF = QF + 1024;
    float* SM = VF + 1024;
    float* gcs = SM; float* bts = SM + 8; float* M1 = SM + 16; float* QKs = SM + 80; float* Tm = SM + 144;
    bf16_t* AW = (bf16_t*)(SM + 256);
    float* UF = (float*)((unsigned char*)AW + 16 * 136 * 2);
    bf16_t* KDT = (bf16_t*)(UF + 1024);
    bf16_t* VNT = KDT + 1024;
    float* RED = (float*)(VNT + 1024);
    float* WSQ = RED + 64;
    const bf16_t* QN = (const bf16_t*)(ws + WS_QN); const bf16_t* KN = (const bf16_t*)(ws + WS_KN); const bf16_t* VS = (const bf16_t*)(ws + WS_VS);
    const float* BETA = (const float*)(ws + WS_BETA); const float* GG = (const float*)(ws + WS_GG);
    const bf16_t* Z = (const bf16_t*)(ws + WS_Z); bf16_t* OG = (bf16_t*)(ws + WS_OG);
    const float* s0 = p.in[4]; const float* onorm = p.in[14];
    f32x4 sreg[8], snext[8];
    unsigned pk = 0, pq = 0, pv = 0, pz0 = 0, pz1 = 0; float pg = 0.f, pb = 0.f;
#define SAMPLE_PREFETCH(it_) do { const int bs_ = (it_) >> 5, h_ = (it_) & 31, hk_ = h_ >> 1, tS_ = TP + bs_ * 8; const int i_ = tid >> 6, d2_ = (tid & 63) * 2; \
        pk = *(const unsigned*)(KN + (size_t)(tS_ + i_) * 2048 + hk_ * 128 + d2_); pq = *(const unsigned*)(QN + (size_t)(tS_ + i_) * 2048 + hk_ * 128 + d2_); \
        pv = *(const unsigned*)(VS + (size_t)(bs_ * 8 + i_) * 4096 + h_ * 128 + d2_); \
        if (tid < 8) { pg = GG[(size_t)(tS_ + tid) * 32 + h_]; pb = BETA[(size_t)(tS_ + tid) * 32 + h_]; } \
        pz0 = Z[(size_t)(tS_ + 2 * fq) * 4096 + h_ * 128 + 16 * w + fr]; pz1 = Z[(size_t)(tS_ + 2 * fq + 1) * 4096 + h_ * 128 + 16 * w + fr]; } while (0)
    { const int tid = tid0, lane = tid & 63, w = tid >> 6, fr = lane & 15, fq = lane >> 4; (void)lane;
    if (first < end) {
#pragma unroll
        for (int mm = 0; mm < 8; ++mm) sreg[mm] = *(const f32x4*)(s0 + (size_t)first * 16384 + (size_t)(16 * mm + fr) * 128 + 16 * w + 4 * fq);
        SAMPLE_PREFETCH(first);
    }
    }
    auto sample_body = [&](const int it, auto FIRST_, auto LAST_) {
        constexpr bool FIRST = decltype(FIRST_)::value, LAST = decltype(LAST_)::value;
        int tid = tid0; asm volatile("" : "+v"(tid));
        const int lane = tid & 63, w = tid >> 6, fr = lane & 15, fq = lane >> 4;
        const int bs = it >> 5, h = it & 31, hk = h >> 1, tS = TP + bs * 8;
#pragma unroll
        for (int mm = 0; mm < 8; ++mm)
#pragma unroll
            for (int jj = 0; jj < 4; ++jj) St[(size_t)(16 * w + 4 * fq + jj) * 136 + 16 * mm + fr] = f2bf(sreg[mm][jj]);
        if constexpr (!LAST && !DIAG) {
#pragma unroll
            for (int mm = 0; mm < 8; ++mm) snext[mm] = *(const f32x4*)(s0 + (size_t)(it + stride) * 16384 + (size_t)(16 * mm + fr) * 128 + 16 * w + 4 * fq);
        }
        { const int i = tid >> 6, d2 = (tid & 63) * 2;
          KF[i * 128 + d2] = __uint_as_float(pk << 16); KF[i * 128 + d2 + 1] = __uint_as_float(pk & 0xffff0000u);
          QF[i * 128 + d2] = __uint_as_float(pq << 16); QF[i * 128 + d2 + 1] = __uint_as_float(pq & 0xffff0000u);
          VF[i * 128 + d2] = __uint_as_float(pv << 16); VF[i * 128 + d2 + 1] = __uint_as_float(pv & 0xffff0000u); }
        if (w == 0) { float g = (tid < 8) ? pg : 0.f;
#pragma unroll
            for (int o = 1; o < 8; o <<= 1) { const float v = __shfl_up(g, o); if (lane >= o) g += v; }
            if (tid < 8) { gcs[tid] = g; bts[tid] = pb; } }
        const float zc0 = __uint_as_float(pz0 << 16), zc1 = __uint_as_float(pz1 << 16);
        if constexpr (!LAST && !DIAG) SAMPLE_PREFETCH(it + stride);
        LDS_BARRIER();
        { const int pid = tid >> 3, i = pid >> 3, j = pid & 7, part = tid & 7; float kkv = 0.f, qkv = 0.f;
#pragma unroll
          for (int d = 0; d < 16; ++d) { const float kj = KF[j * 128 + part * 16 + d]; kkv += KF[i * 128 + part * 16 + d] * kj; qkv += QF[i * 128 + part * 16 + d] * kj; }
          kkv += __shfl_xor(kkv, 1); kkv += __shfl_xor(kkv, 2); kkv += __shfl_xor(kkv, 4);
          qkv += __shfl_xor(qkv, 1); qkv += __shfl_xor(qkv, 2); qkv += __shfl_xor(qkv, 4);
          if (part == 0) { const float dg = gcs[i] - gcs[j]; const float e = (i >= j) ? __expf(dg) : 0.f;
              M1[i * 8 + j] = (i > j) ? bts[i] * kkv * e : 0.f; QKs[i * 8 + j] = qkv * e; } }
        LDS_BARRIER();
        if (tid < 8) { float x[8];
#pragma unroll
            for (int i = 0; i < 8; ++i) { float a = (i == tid) ? 1.f : 0.f;
#pragma unroll
                for (int j = 0; j < 8; ++j) if (j < i) a -= M1[i * 8 + j] * x[j];
                x[i] = a; Tm[i * 8 + tid] = a; } }
        LDS_BARRIER();
#pragma unroll
        for (int r = 0; r < 2; ++r) { const int idx = tid + 512 * r, i = idx >> 7, e = idx & 127; float a = 0.f, c = 0.f;
#pragma unroll
            for (int j = 0; j < 8; ++j) { const float tb = Tm[i * 8 + j] * bts[j]; a += tb * VF[j * 128 + e]; c += tb * __expf(gcs[j]) * KF[j * 128 + e]; }
            UF[idx] = a; AW[i * 136 + e] = f2bf(c); AW[(8 + i) * 136 + e] = f2bf(QF[idx]);
            KDT[e * 8 + i] = f2bf(KF[idx] * __expf(gcs[7] - gcs[i])); }
        LDS_BARRIER();
        { f32x4 acc = {0.f, 0.f, 0.f, 0.f};
#pragma unroll
          for (int kk = 0; kk < 4; ++kk) acc = mfma16(ldfrag(AW + fr * 136 + 32 * kk + 8 * fq), ldfrag(St + (size_t)(16 * w + fr) * 136 + 32 * kk + 8 * fq), acc);
#pragma unroll
          for (int jj = 0; jj < 4; ++jj) WSQ[(4 * fq + jj) * 128 + 16 * w + fr] = acc[jj]; }
        WAVE_LDS_SYNC();
        const int e = 16 * w + fr;
        float vn[8], o2[2];
#pragma unroll
        for (int j = 0; j < 8; ++j) vn[j] = UF[j * 128 + e] - WSQ[j * 128 + e];
        if (fq == 0) *(u32x4*)(VNT + e * 8) = pack8(vn);
#pragma unroll
        for (int r = 0; r < 2; ++r) { const int i = 2 * fq + r; float o = __expf(gcs[i]) * WSQ[(8 + i) * 128 + e];
#pragma unroll
            for (int j = 0; j < 8; ++j) o += QKs[i * 8 + j] * vn[j];
            o2[r] = o; float v = o * o; v += __shfl_xor(v, 1); v += __shfl_xor(v, 2); v += __shfl_xor(v, 4); v += __shfl_xor(v, 8);
            if (fr == 0) RED[w * 8 + i] = v; }
        LDS_BARRIER();
#pragma unroll
        for (int r = 0; r < 2; ++r) { const int i = 2 * fq + r; float tot = 0.f;
#pragma unroll
            for (int ww = 0; ww < 8; ++ww) tot += RED[ww * 8 + i];
            const float rr = rsqrtf(tot * (1.f / 128.f) + EPS); const float z = r ? zc1 : zc0;
            const unsigned short ov = f2bf(o2[r] * rr * onorm[e] * silu_f(z)); if constexpr (!DIAG) OG[(size_t)(tS + i) * 4096 + h * 128 + e] = ov; else asm volatile("" :: "v"((unsigned)ov)); }
        { const float egl = __expf(gcs[7]); bf16x8 af = {0, 0, 0, 0, 0, 0, 0, 0};
          if (fq == 0) af = ldfrag(VNT + (size_t)(16 * w + fr) * 8);
          float* so = p.out + O_SSS + (size_t)it * 16384;
#pragma unroll
          for (int mm = 0; mm < 8; ++mm) { bf16x8 bf = {0, 0, 0, 0, 0, 0, 0, 0}; if (fq == 0) bf = ldfrag(KDT + (size_t)(16 * mm + fr) * 8);
              f32x4 acc = sreg[mm] * egl; acc = mfma16(af, bf, acc);
              if constexpr (!DIAG) *(f32x4*)(so + (size_t)(16 * mm + fr) * 128 + 16 * w + 4 * fq) = acc; else asm volatile("" :: "v"(acc[0]), "v"(acc[3])); } }
#pragma unroll
        for (int mm = 0; mm < 8; ++mm) { if constexpr (!DIAG) sreg[mm] = snext[mm]; }
        LDS_BARRIER();
    };
    const int nit = (first < end) ? (end - first + stride - 1) / stride : 0;
    if (nit == 1) sample_body(first, std::true_type{}, std::true_type{});
    else if (nit >= 2) {
        sample_body(first, std::true_type{}, std::false_type{});
#pragma unroll 1
        for (int q = 1; q + 1 < nit; ++q) sample_body(first + q * stride, std::false_type{}, std::false_type{});
        sample_body(first + (nit - 1) * stride, std::false_type{}, std::true_type{});
    }
}
#undef SAMPLE_PREFETCH
#ifndef G3_SECOND_MODE
#define G3_SECOND_MODE 0
#endif
DEVI void phase_g3(const Params& p, unsigned char* lds, int bid, int nb, int rep) {
    const int mode = rep ? G3_SECOND_MODE : 0;
    if (bid < NCHAIN) { if (mode == 0 || mode == 1) { for (int c = bid; c < 128; c += NCHAIN) g3_chain<false>(p, lds, c); LDS_BARRIER(); g3_sample<false>(p, lds, NS_A + bid, NCHAIN, 4096); }
#if G3_SECOND_MODE == 3
        else if (mode == 3) { for (int c = bid; c < 128; c += NCHAIN) g3_chain<true>(p, lds, c); }
#endif
    } else { if (mode == 0 || mode == 2) g3_sample<false>(p, lds, bid - NCHAIN, nb - NCHAIN, NS_A);
#if G3_SECOND_MODE == 4
        else if (mode == 4) g3_sample<true>(p, lds, bid - NCHAIN, nb - NCHAIN, NS_A);
#endif
    }
}

constexpr int NPHASES = 17;
template <int PH> DEVI void run_phase(const Params& p, unsigned char* lds, int bid, int nb, int rep = 0) {
    unsigned char* ws = p.ws;
    bf16_t* H = (bf16_t*)(ws + WS_H); bf16_t* ACT = (bf16_t*)(ws + WS_ACT); float* X = (float*)(ws + WS_X);
    if constexpr (PH == 0) phase0(p, lds, bid, nb);
    else if constexpr (PH == 1) { EpiBf16<0> E; E.O = ACT; E.ldc = 6144; run_gemm(lds, H, (const bf16_t*)(ws + WS_WT_INA), 6144, 2048, E, bid, nb);
        if (nb == 256 && bid >= 96 && rep == 0) { LDS_BARRIER(); convert_tiles(p, lds, CV_P0_END + (bid - 96), 160, CV_G1_END); } }
    else if constexpr (PH == 2) phase_conv_a(p, bid, nb);
    else if constexpr (PH == 3) run_gemm_sk(lds, (const bf16_t*)(ws + WS_GB), (const bf16_t*)(ws + WS_WT_OUTA), 2048, (bf16_t*)(ws + WS_PA), (bf16_t*)(ws + WS_PB), bid, nb);
    else if constexpr (PH == 4) phase_rms(p, p.in[16], bid, nb, true);
    else if constexpr (PH == 5) { EpiBf16<1> E; E.O = ACT; E.ldc = 8192; run_gemm(lds, H, (const bf16_t*)(ws + WS_WT_UP0), 8192, 2048, E, bid, nb);
        if (nb == 256 && bid >= 128 && rep == 0) { LDS_BARRIER(); convert_tiles(p, lds, CV_G1_END + (bid - 128), 128, CV_NST); } }
    else if constexpr (PH == 6) run_gemm_sk(lds, ACT, (const bf16_t*)(ws + WS_WT_DN0), 8192, (bf16_t*)(ws + WS_PA), (bf16_t*)(ws + WS_PB), bid, nb);
    else if constexpr (PH == 7) phase_rms(p, p.in[9], bid, nb, false);
    else if constexpr (PH == 8) { EpiProj E; E.QKV = (bf16_t*)(ws + WS_QKV); E.Z = (bf16_t*)(ws + WS_Z); E.BA = (float*)(ws + WS_BA); run_gemm(lds, H, (const bf16_t*)(ws + WS_WT_INB), NPROJ_PAD, 2048, E, bid, nb); }
    else if constexpr (PH == 9) phase_g1(p, bid, nb);
    else if constexpr (PH == 10) phase_g2(p, lds, bid, nb);
    else if constexpr (PH == 11) phase_g3(p, lds, bid, nb, rep);
    else if constexpr (PH == 12) run_gemm_sk(lds, (const bf16_t*)(ws + WS_OG), (const bf16_t*)(ws + WS_WT_OUTB), 4096, (bf16_t*)(ws + WS_PA), (bf16_t*)(ws + WS_PB), bid, nb);
    else if constexpr (PH == 13) phase_rms(p, p.in[16] + D, bid, nb, false);
    else if constexpr (PH == 14) { EpiBf16<1> E; E.O = ACT; E.ldc = 8192; run_gemm(lds, H, (const bf16_t*)(ws + WS_WT_UP1), 8192, 2048, E, bid, nb); }
    else if constexpr (PH == 15) run_gemm_sk(lds, ACT, (const bf16_t*)(ws + WS_WT_DN1), 8192, (bf16_t*)(ws + WS_PA), (bf16_t*)(ws + WS_PB), bid, nb);
    else if constexpr (PH == 16) phase_rms_final(p, bid, nb);
}

#if MEGA
#ifndef REPS_INIT
#define REPS_INIT {1,1,1,1,1,1,1,1,1,1,1,1,1,1,1,1,1}
#endif
__device__ constexpr int kReps[NPHASES] = REPS_INIT;
template <int PH> DEVI void mega_phases(const Params& p, unsigned char* shm, cg::grid_group& grid, const XcdBarrier& xb, int bid, int nb) {
#pragma unroll 1
    for (int r = 0; r < kReps[PH]; ++r) { run_phase<PH>(p, shm, bid, nb, r);
        if (PH + 1 < NPHASES || r + 1 < kReps[PH]) xcd_barrier(xb); }
    if constexpr (PH + 1 < NPHASES) mega_phases<PH + 1>(p, shm, grid, xb, bid, nb);
}
__global__ void __launch_bounds__(512, 2) k_mega(Params p) {
    extern __shared__ __attribute__((aligned(16))) unsigned char shm[];
    cg::grid_group grid = cg::this_grid();
    if (gridDim.x == 0x7fffffffu) grid.sync();
    if (threadIdx.x < 4) ((LAS unsigned*)(shm + LDS_XB))[threadIdx.x] = 0u;
    __syncthreads();
    const XcdBarrier xb = xcd_barrier_post((unsigned*)(p.ws + WS_BAR), (volatile LAS unsigned*)(shm + LDS_XB));
    mega_phases<0>(p, shm, grid, xb, (int)blockIdx.x, (int)gridDim.x);
}
#else
template <int PH> __global__ void __launch_bounds__(512, 2) k_phase(Params p) {
    extern __shared__ __attribute__((aligned(16))) unsigned char shm[];
    run_phase<PH>(p, shm, blockIdx.x, gridDim.x);
}
template <int PH> static void launch_phase(const Params& p, int grid, hipStream_t stream) {
    static bool attr = false;
    if (!attr) { (void)hipFuncSetAttribute((const void*)k_phase<PH>, hipFuncAttributeMaxDynamicSharedMemorySize, LDS_BYTES); attr = true; }
    hipLaunchKernelGGL(k_phase<PH>, dim3(grid), dim3(512), LDS_BYTES, stream, p);
}
template <int PH> static void launch_all(const Params& p, int grid, hipStream_t stream) {
    launch_phase<PH>(p, grid, stream);
    if constexpr (PH + 1 < NPHASES) launch_all<PH + 1>(p, grid, stream);
}
#endif

extern "C" void kernel_launch(void* const* d_in, const int* in_sizes, int n_in, void* d_out, int out_size, void* d_ws, size_t ws_size, hipStream_t stream) {
    static int grid = 0;
    if (grid == 0) {
        if (n_in != 20 || ws_size < WS_END) { fprintf(stderr, "kernel_launch: need 20 inputs and %zu bytes of workspace (got %d, %zu)\n", (size_t)WS_END, n_in, ws_size); grid = -1; return; }
        int dev = 0, cus = 0, per_cu = 0;
        (void)hipGetDevice(&dev); (void)hipDeviceGetAttribute(&cus, hipDeviceAttributeMultiprocessorCount, dev);
#if MEGA
        if (hipFuncSetAttribute((const void*)k_mega, hipFuncAttributeMaxDynamicSharedMemorySize, LDS_BYTES) != hipSuccess) { fprintf(stderr, "kernel_launch: hipFuncSetAttribute failed\n"); grid = -1; return; }
        if (hipOccupancyMaxActiveBlocksPerMultiprocessor(&per_cu, (const void*)k_mega, 512, LDS_BYTES) != hipSuccess || per_cu < 1) { fprintf(stderr, "kernel_launch: occupancy query says %d blocks per CU\n", per_cu); grid = -1; return; }
#endif
        grid = cus;
        if (grid < NCHAIN + 1) { fprintf(stderr, "kernel_launch: %d CUs is too few\n", grid); grid = -1; return; }
    }
    if (grid < 0) return;
    Params p{};
    for (int i = 0; i < 20; ++i) p.in[i] = (const float*)d_in[i];
    p.out = (float*)d_out; p.ws = (unsigned char*)d_ws;
#if MEGA
    if (hipMemsetAsync((unsigned char*)d_ws + WS_BAR, 0, 16384, stream) != hipSuccess) { fprintf(stderr, "kernel_launch: hipMemsetAsync of the barrier words failed\n"); return; }
    void* args[] = {&p};
    hipError_t e = hipLaunchCooperativeKernel((const void*)k_mega, dim3(grid), dim3(512), args, LDS_BYTES, stream);
    if (e != hipSuccess) fprintf(stderr, "kernel_launch: cooperative launch failed: %s (grid %d)\n", hipGetErrorString(e), grid);
#else
    launch_all<0>(p, grid, stream);
#endif
}
```

```cpp
#include <hip/hip_runtime.h>
#include <hip/hip_cooperative_groups.h>
#include <cstdio>
#include <cstdint>
#include <type_traits>
namespace cg = cooperative_groups;
namespace pg8 {
#define PG8_LAS __attribute__((address_space(3)))
typedef unsigned short bf16_t;
typedef short bf16x8 __attribute__((ext_vector_type(8)));
typedef float f32x4 __attribute__((ext_vector_type(4)));
typedef unsigned u32x4 __attribute__((ext_vector_type(4)));
constexpr int BM = 256, BK = 64, HALF = 128, HTB = HALF * BK * 2  , STAGE_BYTES = 8 * HTB, NXCD = 8, WGM = 8;

__host__ __device__ __forceinline__ int lds_byte(int r, int c) { const int st = (r >> 4) * 2 + (c >> 5), rr = r & 15, cc = c & 31, ob = rr * 64 + cc * 2; return st * 1024 + (ob ^ (((ob >> 9) & 1) << 5)); }
__host__ __device__ __forceinline__ void stage_rc(int b, int& R, int& C) { const int st = b / 1024, sb = b % 1024, swz = sb ^ (((sb >> 9) & 1) << 5); R = (st >> 1) * 16 + swz / 64; C = (st & 1) * 32 + (swz % 64) / 2; }
__host__ __device__ __forceinline__ int perm32(int rho) { const int n = rho >> 4, i = rho & 15; return 8 * (i >> 2) + 4 * n + (i & 3); }

struct Unit { int pm, pn, kt0, nt; };
struct Gemm { const bf16_t* A; const bf16_t* Bt; int M, N, K; };

struct StaticOrder {
    int nM, nN, nwg, G, c, ntk;
    __host__ __device__ void init(int M, int N, int G_, int c_, int K_) { nM = M / BM; nN = N / BM; nwg = nM * nN; G = G_; c = c_; ntk = K_ / BK; }
    __host__ __device__ bool next(int i, Unit& u) const {
        const long L = (long)i * G + c; if (L >= nwg) return false;
        int wgid = (int)L; { const int q = nwg / NXCD, r = nwg % NXCD, xcd = wgid % NXCD, off = wgid / NXCD; wgid = (xcd < r ? xcd * (q + 1) : r * (q + 1) + (xcd - r) * q) + off; }
        const int nig = WGM * nN, gid = wgid / nig, fm = gid * WGM, gsz = (nM - fm) < WGM ? (nM - fm) : WGM;
        u.pm = fm + ((wgid % nig) % gsz); u.pn = (wgid % nig) / gsz; u.kt0 = 0; u.nt = ntk; return true;
    }
    __device__ __forceinline__ void a_ready(const Unit&) const {}
    __device__ __forceinline__ void done(const Unit&) const {}
};
typedef __bf16 bf16v2_t __attribute__((ext_vector_type(2)));
typedef float f32v2_t __attribute__((ext_vector_type(2)));
__device__ __forceinline__ unsigned cvt_pk_bf16(float lo, float hi) { const f32v2_t v = {lo, hi}; const bf16v2_t b = __builtin_convertvector(v, bf16v2_t); return __builtin_bit_cast(unsigned, b); }

template <class Epi, class Sched, bool STAMP = false>
__device__ __forceinline__ void gemm_phase(PG8_LAS unsigned char* lds, const Gemm g, const Sched& S, const Epi& E, unsigned long long* stamps) {
    int tid_ = (int)threadIdx.x; asm volatile("" : "+v"(tid_)); const int tid = tid_, wid = __builtin_amdgcn_readfirstlane(tid >> 6), lane = tid & 63, wr = wid >> 2, wc = wid & 3, fr = lane & 15, fq = lane >> 4;
    const int K = g.K;
    int ts_lo = 0, ts_hi = 0, nts = 0; const unsigned long long rt_entry = STAMP ? (unsigned long long)wall_clock64() : 0ull;
#define PG8_STAMP() do { if (STAMP && wid == 0 && nts < 64) { const unsigned long long _c = (unsigned long long)clock64(); \
        ts_lo = (lane == nts) ? (int)(unsigned)_c : ts_lo; ts_hi = (lane == nts) ? (int)(unsigned)(_c >> 32) : ts_hi; ++nts; } } while (0)
    PG8_STAMP();
    unsigned voffA[2], voffB[2];
#pragma unroll
    for (int i = 0; i < 2; ++i) { int R, C; stage_rc(tid * 16 + i * 8192, R, C); const int Rb = Epi::PERM ? ((R & ~31) + perm32(R & 31)) : R;
        voffA[i] = (unsigned)(R * K + C) * 2u; voffB[i] = (unsigned)(Rb * K + C) * 2u; }
    const size_t kstep = (size_t)(BK * 2);
    const size_t hstep = (size_t)HALF * K * 2;
    const size_t tstep = 2 * hstep;
    const unsigned ldsw = (unsigned)wid * 1024u;
    const int aoff = lds_byte(wr * 64 + fr, fq * 8), boff = lds_byte(wc * 32 + fr, fq * 8);
#define PG8_SA(b, h) (((b) * 2 + (h)) * HTB)
#define PG8_SB(b, h) ((4 + (b) * 2 + (h)) * HTB)
#define PG8_STAGE(bufoff, gbase, voff) do { _Pragma("unroll") for (int _i = 0; _i < 2; ++_i) \
        __builtin_amdgcn_global_load_lds((const unsigned*)((const char*)(gbase) + (voff)[_i]), (PG8_LAS unsigned*)(lds + (bufoff) + ldsw + _i * 8192), 16, 0, 0); } while (0)
#define PG8_LDA(dst, b, h) do { _Pragma("unroll") for (int m = 0; m < 4; ++m) _Pragma("unroll") for (int k = 0; k < 2; ++k) dst[m][k] = *(const PG8_LAS bf16x8*)(lds + PG8_SA(b, h) + aoff + m * 2048 + k * 1024); } while (0)
#define PG8_LDB(dst, b, h) do { _Pragma("unroll") for (int n = 0; n < 2; ++n) _Pragma("unroll") for (int k = 0; k < 2; ++k) dst[n][k] = *(const PG8_LAS bf16x8*)(lds + PG8_SB(b, h) + boff + n * 2048 + k * 1024); } while (0)
#define PG8_MMA(ai, bj, At, Bt) do { __builtin_amdgcn_s_setprio(1); _Pragma("unroll") for (int m = 0; m < 4; ++m) _Pragma("unroll") for (int n = 0; n < 2; ++n) _Pragma("unroll") for (int k = 0; k < 2; ++k) \
        acc[ai][bj][m][n] = __builtin_amdgcn_mfma_f32_16x16x32_bf16(Bt[n][k], At[m][k], acc[ai][bj][m][n], 0, 0, 0); __builtin_amdgcn_s_setprio(0); } while (0)
#define PG8_WAIT_V(n) asm volatile("s_waitcnt vmcnt(" #n ")" ::: "memory")
#define PG8_WAIT_L(n) asm volatile("s_waitcnt lgkmcnt(" #n ")" ::: "memory")
#define PG8_BAR __builtin_amdgcn_s_barrier()
#define PG8_SCHED __builtin_amdgcn_sched_barrier(0)
    Unit cur, nxt; int ui = 0;
    if (!S.next(0, cur)) return;
    f32x4 acc[2][2][4][2];
#pragma unroll
    for (int a = 0; a < 2; ++a)
#pragma unroll
        for (int b = 0; b < 2; ++b)
#pragma unroll
            for (int m = 0; m < 4; ++m)
#pragma unroll
                for (int n = 0; n < 2; ++n) acc[a][b][m][n] = (f32x4){0.f, 0.f, 0.f, 0.f};
    bf16x8 At[4][2], B0[2][2], B1[2][2];
    const char* cA = (const char*)g.A + (size_t)cur.pm * tstep + (size_t)cur.kt0 * kstep; const char* cB = (const char*)g.Bt + (size_t)cur.pn * tstep + (size_t)cur.kt0 * kstep;
    S.a_ready(cur);
    PG8_STAGE(PG8_SB(0, 0), cB, voffB); PG8_STAGE(PG8_SA(0, 0), cA, voffA); PG8_STAGE(PG8_SB(0, 1), cB + hstep, voffB); PG8_STAGE(PG8_SA(0, 1), cA + hstep, voffA);
    if (wr == 1) PG8_BAR;
    PG8_WAIT_V(4); PG8_BAR;
    PG8_STAGE(PG8_SB(1, 0), cB + kstep, voffB); PG8_STAGE(PG8_SA(1, 0), cA + kstep, voffA); PG8_STAGE(PG8_SB(1, 1), cB + hstep + kstep, voffB);
    PG8_WAIT_V(6); PG8_BAR;
    PG8_STAMP();
    for (;;) {
        const bool has_next = S.next(ui + 1, nxt);
        const char* nA = has_next ? (const char*)g.A + (size_t)nxt.pm * tstep + (size_t)nxt.kt0 * kstep : cA; const char* nB = has_next ? (const char*)g.Bt + (size_t)nxt.pn * tstep + (size_t)nxt.kt0 * kstep : cB;
        const int nt = cur.nt;
        for (int t = 0; t < nt; t += 2) {
            const bool last = (t == nt - 2);
            const char* a1 = cA + (size_t)(t + 1) * kstep;
            const char* a2 = last ? nA : cA + (size_t)(t + 2) * kstep; const char* b2 = last ? nB : cB + (size_t)(t + 2) * kstep;
            const char* a3 = a2 + kstep; const char* b3 = b2 + kstep;
            if (last && has_next) S.a_ready(nxt);
            PG8_LDB(B0, 0, 0); PG8_SCHED; PG8_LDA(At, 0, 0); PG8_STAGE(PG8_SA(1, 1), a1 + hstep, voffA);
            PG8_WAIT_L(8); PG8_BAR; PG8_WAIT_L(0); PG8_MMA(0, 0, At, B0); PG8_BAR; PG8_SCHED;
            PG8_LDB(B1, 0, 1); PG8_STAGE(PG8_SB(0, 0), b2, voffB);
            PG8_BAR; PG8_WAIT_L(0); PG8_MMA(0, 1, At, B1); PG8_BAR;
            PG8_LDA(At, 0, 1); PG8_STAGE(PG8_SA(0, 0), a2, voffA);
            PG8_BAR; PG8_WAIT_L(0); PG8_MMA(1, 0, At, B0); PG8_BAR; PG8_SCHED;
            PG8_STAGE(PG8_SB(0, 1), b2 + hstep, voffB);
            PG8_WAIT_V(6); PG8_BAR; PG8_MMA(1, 1, At, B1); PG8_BAR;
            PG8_LDB(B0, 1, 0); PG8_SCHED; PG8_LDA(At, 1, 0); PG8_STAGE(PG8_SA(0, 1), a2 + hstep, voffA);
            PG8_WAIT_L(8); PG8_BAR; PG8_WAIT_L(0); PG8_MMA(0, 0, At, B0); PG8_BAR; PG8_SCHED;
            PG8_LDB(B1, 1, 1); PG8_STAGE(PG8_SB(1, 0), b3, voffB);
            PG8_BAR; PG8_WAIT_L(0); PG8_MMA(0, 1, At, B1); PG8_BAR;
            PG8_LDA(At, 1, 1); PG8_STAGE(PG8_SA(1, 0), a3, voffA);
            PG8_BAR; PG8_WAIT_L(0); PG8_MMA(1, 0, At, B0); PG8_BAR; PG8_SCHED;
            PG8_STAGE(PG8_SB(1, 1), b3 + hstep, voffB);
            PG8_WAIT_V(6); PG8_BAR; PG8_MMA(1, 1, At, B1); PG8_BAR;
        }
        PG8_STAMP();
        if constexpr (!Epi::AFTER_DRAIN) { E(acc, cur, wr, wc, fr, fq); S.done(cur); }
        PG8_STAMP();
        if (!has_next) break;
#pragma unroll
        for (int a = 0; a < 2; ++a)
#pragma unroll
            for (int b = 0; b < 2; ++b)
#pragma unroll
                for (int m = 0; m < 4; ++m)
#pragma unroll
                    for (int n = 0; n < 2; ++n) acc[a][b][m][n] = (f32x4){0.f, 0.f, 0.f, 0.f};
        cur = nxt; cA = nA; cB = nB; ++ui;
    }
    PG8_WAIT_V(0);
    if (wr == 0) PG8_BAR;
    PG8_BAR;
    if constexpr (Epi::AFTER_DRAIN) { E.fused(acc, cur, wr, wc, fr, fq, lds, wid, lane); S.done(cur); }
    PG8_STAMP();
    if (STAMP && wid == 0) { stamps[lane] = lane < nts ? (((unsigned long long)(unsigned)ts_hi << 32) | (unsigned)ts_lo) : 0ull;
        if (lane == 62) stamps[62] = rt_entry; if (lane == 63) stamps[63] = (unsigned long long)wall_clock64(); }
#undef PG8_STAMP
#undef PG8_SA
#undef PG8_SB
#undef PG8_STAGE
#undef PG8_LDA
#undef PG8_LDB
#undef PG8_MMA
#undef PG8_WAIT_V
#undef PG8_WAIT_L
#undef PG8_BAR
#undef PG8_SCHED
}
}

#define XB_TMO      128
#define XB_XCNT(j)  (256  + 64 * (j))
#define XB_XSUB(j)  (1280 + 64 * (j))
#define XB_XGEN(j)  (2304 + 64 * (j))
#define XB_TOP      3328
#define XB_TOPGEN   3392
#define XCD_BAR_WORDS 3456
#define XB_SPIN_CAP (1u << 18)
#define LAS __attribute__((address_space(3)))

__device__ __forceinline__ unsigned xb_ld(unsigned* p)              { return __hip_atomic_load(p, __ATOMIC_RELAXED, __HIP_MEMORY_SCOPE_AGENT); }
__device__ __forceinline__ unsigned xb_add(unsigned* p, unsigned v) { return __hip_atomic_fetch_add(p, v, __ATOMIC_RELAXED, __HIP_MEMORY_SCOPE_AGENT); }
__device__ __forceinline__ unsigned xb_xcc_id() { return (unsigned)__builtin_amdgcn_s_getreg((3 << 11) | 20) & 0xFu; }
#define XB_SPIN(cond, bar) do { unsigned _sp = 0; while (cond) { __builtin_amdgcn_s_sleep(1); \
    if ((++_sp & 255u) == 0u) { if (xb_ld(&(bar)[XB_TMO])) break; if (_sp > XB_SPIN_CAP) { atomicAdd(&(bar)[XB_TMO], 1u); break; } } } } while (0)

struct XcdBarrier {
    unsigned* bar; unsigned x;
    volatile LAS unsigned* st;
};

__device__ __forceinline__ XcdBarrier xcd_barrier_post(unsigned* bar, volatile LAS unsigned* st) {
    XcdBarrier b; b.bar = bar; b.x = xb_xcc_id(); b.st = st;
    if (threadIdx.x == 0) (void)xb_add(&bar[XB_XCNT(b.x)], 1u);
    return b;
}
__device__ __forceinline__ void xcd_barrier_complete(unsigned* bar, unsigned x, unsigned& nloc, unsigned& nx) {
    const unsigned G = gridDim.x * gridDim.y * gridDim.z;
    unsigned sum, cnt, mine, sp = 0u;
    for (;;) {
        sum = 0u; cnt = 0u; mine = 0u;
#pragma unroll
        for (unsigned j = 0; j < 16; ++j) { const unsigned c = xb_ld(&bar[XB_XCNT(j)]); sum += c; cnt += (c > 0u) ? 1u : 0u; mine = (j == x) ? c : mine; }
        if (sum == G) break;
        __builtin_amdgcn_s_sleep(1);
        if ((++sp & 255u) == 0u) { if (xb_ld(&bar[XB_TMO])) break; if (sp > XB_SPIN_CAP) { atomicAdd(&bar[XB_TMO], 1u); break; } }
    }
    nloc = mine > 0u ? mine : 1u; nx = cnt > 0u ? cnt : 1u;
}

__device__ __forceinline__ void xcd_barrier(const XcdBarrier& b) {
    asm volatile("s_waitcnt vmcnt(0)" ::: "memory");
    __syncthreads();
    if (threadIdx.x == 0) {
        unsigned* bar = b.bar;
        __builtin_amdgcn_s_waitcnt(0);
        unsigned nloc = b.st[0], nx = b.st[1];
        if (nloc == 0u) { xcd_barrier_complete(bar, b.x, nloc, nx); b.st[0] = nloc; b.st[1] = nx; }
        const unsigned old = xb_add(&bar[XB_XSUB(b.x)], 1u);
        const unsigned gen = old / nloc;
        if (old + 1u == (gen + 1u) * nloc) {
            __builtin_amdgcn_fence(__ATOMIC_RELEASE, "agent");
            asm volatile("s_waitcnt vmcnt(0)" ::: "memory");
            const unsigned og = xb_add(&bar[XB_TOP], 1u);
            const unsigned tg = og / nx;
            if (og + 1u == (tg + 1u) * nx) xb_add(&bar[XB_TOPGEN], 1u);
            else XB_SPIN(xb_ld(&bar[XB_TOPGEN]) == tg, bar);
            __builtin_amdgcn_fence(__ATOMIC_ACQUIRE, "agent");
            xb_add(&bar[XB_XGEN(b.x)], 1u);
            asm volatile("s_waitcnt vmcnt(0)" ::: "memory");
        } else {
            XB_SPIN(xb_ld(&bar[XB_XGEN(b.x)]) == gen, bar);
            __builtin_amdgcn_fence(__ATOMIC_ACQUIRE, "agent");
            asm volatile("s_waitcnt vmcnt(0)" ::: "memory");
        }
    }
    __syncthreads();
}

using pg8::bf16_t; using pg8::bf16x8; using pg8::f32x4; using pg8::u32x4;
#define DEVI __device__ __forceinline__
DEVI int otid() { int t = (int)hipThreadIdx_x; asm volatile("" : "+v"(t)); return t; }
#ifndef MEGA
#define MEGA 1
#endif

constexpr int D = 2048, TP = 8192, TS = 1024, T = 9216, DFF = 8192;
constexpr int NPROJ = 12352, NPROJ_PAD = 12544;
constexpr float EPS = 1e-6f;
constexpr int LDS_XB = 73728 + 65536;
constexpr int LDS_BYTES = LDS_XB + 16;
constexpr int NCHAIN = 128;
constexpr int NS_A = 32 * 128;

constexpr size_t WS_WT_INA = 0;
constexpr size_t WS_WT_OUTA = WS_WT_INA + (size_t)6144 * 2048 * 2;
constexpr size_t WS_WT_UP0 = WS_WT_OUTA + (size_t)2048 * 2048 * 2;
constexpr size_t WS_WT_DN0 = WS_WT_UP0 + (size_t)8192 * 2048 * 2;
constexpr size_t WS_WT_INB = WS_WT_DN0 + (size_t)8192 * 2048 * 2;
constexpr size_t WS_WT_OUTB = WS_WT_INB + (size_t)NPROJ_PAD * 2048 * 2;
constexpr size_t WS_WT_UP1 = WS_WT_OUTB + (size_t)2048 * 4096 * 2;
constexpr size_t WS_WT_DN1 = WS_WT_UP1 + (size_t)8192 * 2048 * 2;
constexpr size_t WS_X = WS_WT_DN1 + (size_t)8192 * 2048 * 2;
constexpr size_t WS_H = WS_X + (size_t)T * D * 4;
constexpr size_t WS_GB = WS_H + (size_t)T * D * 2;
constexpr size_t WS_OG = WS_H;
constexpr size_t WS_ACT = WS_GB + (size_t)T * D * 2;
constexpr size_t WS_QKV = WS_ACT;
constexpr size_t WS_Z = WS_ACT + (size_t)T * 8192 * 2;
constexpr size_t WS_BA = WS_ACT + (size_t)T * 12288 * 2;
constexpr size_t WS_QN = WS_BA + (size_t)T * 64 * 4;
constexpr size_t WS_KN = WS_QN + (size_t)T * D * 2;
constexpr size_t WS_VS = WS_KN + (size_t)T * D * 2;
constexpr size_t WS_KT = WS_VS + (size_t)TS * 4096 * 2;
constexpr size_t WS_VT = WS_KT + (size_t)TP * 2048 * 2;
constexpr size_t WS_BETA = WS_VT + (size_t)TP * 4096 * 2;
constexpr size_t WS_GG = WS_BETA + (size_t)T * 32 * 4;
constexpr size_t WS_GC = WS_GG + (size_t)T * 32 * 4;
constexpr size_t WS_UT = WS_GC + (size_t)TP * 32 * 4;
constexpr size_t WS_WW = WS_UT + (size_t)TP * 4096 * 2;
constexpr size_t WS_QKM = WS_WW + (size_t)TP * 4096 * 2;
constexpr size_t WS_PB = WS_QKM + (size_t)4096 * 4096 * 2;
constexpr size_t WS_PA = WS_PB + (size_t)T * D * 2;
constexpr size_t WS_BAR = WS_PB + (size_t)T * D * 4;
constexpr size_t WS_END = WS_BAR + 16384;

constexpr size_t O_YP = 0;
constexpr size_t O_YS = O_YP + (size_t)TP * D;
constexpr size_t O_CAP = O_YS + (size_t)TS * D;
constexpr size_t O_CBP = O_CAP + (size_t)4 * 2 * 2048;
constexpr size_t O_SSP = O_CBP + (size_t)4 * 3 * 8192;
constexpr size_t O_CAS = O_SSP + (size_t)4 * 32 * 16384;
constexpr size_t O_CBS = O_CAS + (size_t)128 * 2 * 2048;
constexpr size_t O_SSS = O_CBS + (size_t)128 * 3 * 8192;

struct Params { const float* in[20]; float* out; unsigned char* ws; };

DEVI float bf2f(unsigned short b) { return __uint_as_float(((unsigned)b) << 16); }
DEVI unsigned pk2(float lo, float hi) { return pg8::cvt_pk_bf16(lo, hi); }
DEVI unsigned short f2bf(float f) { return (unsigned short)(pk2(f, 0.f) & 0xffffu); }
DEVI float silu_f(float a) { return a * __builtin_amdgcn_rcpf(1.f + __expf(-a)); }
DEVI float wave_sum(float v) {
#pragma unroll
    for (int o = 1; o < 64; o <<= 1) v += __shfl_xor(v, o);
    return v;
}
DEVI void unpack8(u32x4 w, float (&f)[8]) {
    f[0] = __uint_as_float(w.x << 16); f[1] = __uint_as_float(w.x & 0xffff0000u);
    f[2] = __uint_as_float(w.y << 16); f[3] = __uint_as_float(w.y & 0xffff0000u);
    f[4] = __uint_as_float(w.z << 16); f[5] = __uint_as_float(w.z & 0xffff0000u);
    f[6] = __uint_as_float(w.w << 16); f[7] = __uint_as_float(w.w & 0xffff0000u);
}
DEVI u32x4 pack8(const float (&f)[8]) { u32x4 w; w.x = pk2(f[0], f[1]); w.y = pk2(f[2], f[3]); w.z = pk2(f[4], f[5]); w.w = pk2(f[6], f[7]); return w; }
DEVI void ld8f(const float* p, float (&f)[8]) { f32x4 a = *(const f32x4*)p, b = *(const f32x4*)(p + 4); f[0] = a.x; f[1] = a.y; f[2] = a.z; f[3] = a.w; f[4] = b.x; f[5] = b.y; f[6] = b.z; f[7] = b.w; }
DEVI void st8f(float* p, const float (&f)[8]) { *(f32x4*)p = (f32x4){f[0], f[1], f[2], f[3]}; *(f32x4*)(p + 4) = (f32x4){f[4], f[5], f[6], f[7]}; }
DEVI f32x4 mfma16(bf16x8 a, bf16x8 b, f32x4 c) { return __builtin_amdgcn_mfma_f32_16x16x32_bf16(a, b, c, 0, 0, 0); }
DEVI bf16x8 ldfrag(const bf16_t* p) { return *(const bf16x8*)p; }
#define LDS_BARRIER() do { asm volatile("s_waitcnt lgkmcnt(0)" ::: "memory"); __builtin_amdgcn_s_barrier(); asm volatile("" ::: "memory"); } while (0)
#define WAVE_LDS_SYNC() do { asm volatile("s_waitcnt lgkmcnt(0)" ::: "memory"); __builtin_amdgcn_wave_barrier(); } while (0)

template <int ACT> struct EpiBf16 {
    static constexpr bool PERM = true, AFTER_DRAIN = false;
    bf16_t* O; int ldc;
    DEVI void operator()(const f32x4 (&acc)[2][2][4][2], const pg8::Unit& u, int wr, int wc, int fr, int fq) const {
        const int row0 = u.pm * 256 + wr * 64 + fr, col0 = u.pn * 256 + wc * 32 + 8 * fq;
#pragma unroll
        for (int ai = 0; ai < 2; ++ai)
#pragma unroll
            for (int m = 0; m < 4; ++m) { bf16_t* rowp = O + (size_t)(row0 + ai * 128 + m * 16) * ldc + col0;
#pragma unroll
                for (int bj = 0; bj < 2; ++bj) { f32x4 v0 = acc[ai][bj][m][0], v1 = acc[ai][bj][m][1];
                    if (ACT == 1) {
#pragma unroll
                        for (int j = 0; j < 4; ++j) { float a = fmaxf(v0[j], 0.f), b = fmaxf(v1[j], 0.f); v0[j] = a * a; v1[j] = b * b; } }
                    u32x4 w; w.x = pk2(v0[0], v0[1]); w.y = pk2(v0[2], v0[3]); w.z = pk2(v1[0], v1[1]); w.w = pk2(v1[2], v1[3]);
                    *(u32x4*)(rowp + bj * 128) = w; } }
    }
};
struct EpiResid {
    static constexpr bool PERM = false, AFTER_DRAIN = false;
    float* X; const float* rp; const float* rs;
    DEVI void operator()(const f32x4 (&acc)[2][2][4][2], const pg8::Unit& u, int wr, int wc, int fr, int fq) const {
        const int row0 = u.pm * 256 + wr * 64 + fr, col0 = u.pn * 256 + wc * 32 + 4 * fq;
        const float* R = (u.pm * 256 < TP) ? rp : (rs - (size_t)TP * D);
#pragma unroll
        for (int ai = 0; ai < 2; ++ai)
#pragma unroll
            for (int m = 0; m < 4; ++m) { const size_t ro = (size_t)(row0 + ai * 128 + m * 16) * D + col0;
#pragma unroll
                for (int bj = 0; bj < 2; ++bj)
#pragma unroll
                    for (int n = 0; n < 2; ++n) { const f32x4 r = *(const f32x4*)(R + ro + bj * 128 + n * 16); *(f32x4*)(X + ro + bj * 128 + n * 16) = acc[ai][bj][m][n] + r; } }
    }
};
struct EpiProj {
    static constexpr bool PERM = true, AFTER_DRAIN = false;
    bf16_t* QKV; bf16_t* Z; float* BA;
    DEVI void operator()(const f32x4 (&acc)[2][2][4][2], const pg8::Unit& u, int wr, int wc, int fr, int fq) const {
        const int row0 = u.pm * 256 + wr * 64 + fr; const int colt = u.pn * 256;
        if (colt < 12288) {
            bf16_t* base; int ldc, c0;
            if (colt < 8192) { base = QKV; ldc = 8192; c0 = colt; } else { base = Z; ldc = 4096; c0 = colt - 8192; }
            const int col0 = c0 + wc * 32 + 8 * fq;
#pragma unroll
            for (int ai = 0; ai < 2; ++ai)
#pragma unroll
                for (int m = 0; m < 4; ++m) { bf16_t* rowp = base + (size_t)(row0 + ai * 128 + m * 16) * ldc + col0;
#pragma unroll
                    for (int bj = 0; bj < 2; ++bj) { const f32x4 v0 = acc[ai][bj][m][0], v1 = acc[ai][bj][m][1];
                        u32x4 w; w.x = pk2(v0[0], v0[1]); w.y = pk2(v0[2], v0[3]); w.z = pk2(v1[0], v1[1]); w.w = pk2(v1[2], v1[3]);
                        *(u32x4*)(rowp + bj * 128) = w; } }
        } else if (wc < 2) {
#pragma unroll
            for (int ai = 0; ai < 2; ++ai)
#pragma unroll
                for (int m = 0; m < 4; ++m) { float* rowp = BA + (size_t)(row0 + ai * 128 + m * 16) * 64 + wc * 32 + 8 * fq;
                    *(f32x4*)(rowp) = acc[ai][0][m][0]; *(f32x4*)(rowp + 4) = acc[ai][0][m][1]; }
        }
    }
};

struct StreamKOrder {
    int ntk, per, c;
    DEVI void init(int K, int G, int c_) { ntk = K / 64; per = (288 * ntk) / G; c = c_; }
    DEVI bool next(int i, pg8::Unit& u) const {
        const int s = c * per, e = s + per; int p0 = s;
        if (i >= 1) p0 = (s / ntk + 1) * ntk;
        if (i >= 2) p0 = (s / ntk + 2) * ntk;
        if (p0 >= e) return false;
        const int L = p0 / ntk, k = L / 9, r = L - 9 * k; int pend = (L + 1) * ntk; if (pend > e) pend = e;
        u.pn = k & 7; u.pm = r * 4 + (k >> 3); u.kt0 = p0 - L * ntk; u.nt = pend - p0; return true;
    }
    DEVI void a_ready(const pg8::Unit&) const {}
    DEVI void done(const pg8::Unit&) const {}
};
DEVI bool sk_has_pb(int pm, int pn) { const int k = (pm & 3) * 8 + pn, r = pm >> 2, L = r + 9 * k; return ((8 * L) % 9) >= 2; }
struct EpiSK {
    static constexpr bool PERM = true, AFTER_DRAIN = false;
    bf16_t* PA; bf16_t* PB;
    DEVI void operator()(const f32x4 (&acc)[2][2][4][2], const pg8::Unit& u, int wr, int wc, int fr, int fq) const {
        const int row0 = u.pm * 256 + wr * 64 + fr, col0 = u.pn * 256 + wc * 32 + 8 * fq;
        bf16_t* P = (u.kt0 == 0) ? PA : PB;
#pragma unroll
        for (int ai = 0; ai < 2; ++ai)
#pragma unroll
            for (int m = 0; m < 4; ++m) { bf16_t* rowp = P + (size_t)(row0 + ai * 128 + m * 16) * D + col0;
#pragma unroll
                for (int bj = 0; bj < 2; ++bj) { const f32x4 v0 = acc[ai][bj][m][0], v1 = acc[ai][bj][m][1];
                    u32x4 w; w.x = pk2(v0[0], v0[1]); w.y = pk2(v0[2], v0[3]); w.z = pk2(v1[0], v1[1]); w.w = pk2(v1[2], v1[3]);
                    *(u32x4*)(rowp + bj * 128) = w; } }
    }
};
DEVI void run_gemm_sk(unsigned char* lds, const bf16_t* A, const bf16_t* Bt, int K, bf16_t* PA, bf16_t* PB, int bid, int nb) {
    pg8::Gemm g; g.A = A; g.Bt = Bt; g.M = T; g.N = 2048; g.K = K;
    StreamKOrder S; S.init(K, nb, bid);
    EpiSK E; E.PA = PA; E.PB = PB;
    pg8::gemm_phase<EpiSK, StreamKOrder, false>((PG8_LAS unsigned char*)lds, g, S, E, nullptr);
}
template <class Epi> DEVI void run_gemm(unsigned char* lds, const bf16_t* A, const bf16_t* Bt, int N, int K, const Epi& E, int bid, int nb) {
    pg8::Gemm g; g.A = A; g.Bt = Bt; g.M = T; g.N = N; g.K = K;
    pg8::StaticOrder S; S.init(T, N, nb, bid, K);
    pg8::gemm_phase<Epi, pg8::StaticOrder, false>((PG8_LAS unsigned char*)lds, g, S, E, nullptr);
}

DEVI void transpose_load(const float* W, int N, int k0, int n0, int lane, f32x4 (&v)[16]) {
    const float* src = W + (size_t)(k0 + (lane >> 4)) * N + n0 + (lane & 15) * 4;
#pragma unroll
    for (int i = 0; i < 16; ++i) v[i] = *(const f32x4*)(src + (size_t)(4 * i) * N);
}
DEVI void transpose_store(const f32x4 (&v)[16], int K, bf16_t* WT, float* scr, int k0, int n0, int lane) {
#pragma unroll
    for (int i = 0; i < 16; ++i) { float* d = scr + (4 * i + (lane >> 4)) * 65 + (lane & 15) * 4; d[0] = v[i].x; d[1] = v[i].y; d[2] = v[i].z; d[3] = v[i].w; }
    WAVE_LDS_SYNC();
    const int c = lane & 7;
#pragma unroll
    for (int j = 0; j < 8; ++j) { const int n = (lane >> 3) + 8 * j; const float* s = scr + (8 * c) * 65 + n;
        u32x4 o; o.x = pk2(s[0 * 65], s[1 * 65]); o.y = pk2(s[2 * 65], s[3 * 65]); o.z = pk2(s[4 * 65], s[5 * 65]); o.w = pk2(s[6 * 65], s[7 * 65]);
        *(u32x4*)(WT + (size_t)(n0 + n) * K + k0 + 8 * c) = o; }
    WAVE_LDS_SYNC();
}
DEVI f32x4 ldpb4(const bf16_t* pb, int idx4) { const unsigned long long r = ((const unsigned long long*)pb)[idx4]; return (f32x4){__uint_as_float((unsigned)r << 16), __uint_as_float((unsigned)r & 0xffff0000u), __uint_as_float((unsigned)(r >> 32) << 16), __uint_as_float((unsigned)(r >> 32) & 0xffff0000u)}; }
template <int MODE> DEVI void rms_row_bf16(const float* xr, const float* w, bf16_t* o, int lane, float* xcopy = nullptr, const bf16_t* pa = nullptr, const bf16_t* pb = nullptr, int pm = 0) {
    f32x4 v[8], q[8], qa[8]; float s = 0.f;
#pragma unroll
    for (int j = 0; j < 8; ++j) { v[j] = ((const f32x4*)xr)[lane + 64 * j];
        if (MODE == 2) { qa[j] = ldpb4(pa, lane + 64 * j); if (sk_has_pb(pm, j)) q[j] = ldpb4(pb, lane + 64 * j); else q[j] = (f32x4){0.f, 0.f, 0.f, 0.f}; } }
    f32x4 ww[8];
#pragma unroll
    for (int j = 0; j < 8; ++j) ww[j] = ((const f32x4*)w)[lane + 64 * j];
#pragma unroll
    for (int j = 0; j < 8; ++j) { if (MODE == 2) v[j] = v[j] + (qa[j] + q[j]); s += (v[j].x * v[j].x + v[j].y * v[j].y) + (v[j].z * v[j].z + v[j].w * v[j].w); }
    const float r = rsqrtf(wave_sum(s) * (1.f / D) + EPS);
#pragma unroll
    for (int j = 0; j < 8; ++j) { if (MODE == 2) ((f32x4*)xcopy)[lane + 64 * j] = v[j];
        const unsigned lo = pk2(v[j].x * r * ww[j].x, v[j].y * r * ww[j].y), hi = pk2(v[j].z * r * ww[j].z, v[j].w * r * ww[j].w);
        ((unsigned long long*)o)[lane + 64 * j] = (unsigned long long)lo | ((unsigned long long)hi << 32); }
}
DEVI void rms_row_f32(const float* xr, const float* w, float* o, int lane, const bf16_t* pa, const bf16_t* pb, int pm) {
    f32x4 v[8], q[8], ww[8]; float s = 0.f;
#pragma unroll
    for (int j = 0; j < 8; ++j) { v[j] = ((const f32x4*)xr)[lane + 64 * j]; if (sk_has_pb(pm, j)) q[j] = ldpb4(pb, lane + 64 * j); else q[j] = (f32x4){0.f, 0.f, 0.f, 0.f}; ww[j] = ((const f32x4*)w)[lane + 64 * j]; }
#pragma unroll
    for (int j = 0; j < 8; ++j) { v[j] = v[j] + (q[j] + ldpb4(pa, lane + 64 * j)); s += (v[j].x * v[j].x + v[j].y * v[j].y) + (v[j].z * v[j].z + v[j].w * v[j].w); }
    const float r = rsqrtf(wave_sum(s) * (1.f / D) + EPS);
#pragma unroll
    for (int j = 0; j < 8; ++j) ((f32x4*)o)[lane + 64 * j] = (f32x4){v[j].x * r * ww[j].x, v[j].y * r * ww[j].y, v[j].z * r * ww[j].z, v[j].w * r * ww[j].w};
}
constexpr int CV_S0 = 8 * 48, CV_S1 = 8 * 16, CV_S2 = 8 * 64, CV_S3 = 32 * 16, CV_S4 = 8 * 97, CV_S5 = 16 * 16;
constexpr int CV_NST = CV_S0 + CV_S1 + CV_S2 + CV_S3 + CV_S4 + CV_S5 + CV_S2 + CV_S3;
constexpr int CV_G1 = 160 * 4, CV_G3 = 128 * 4, CV_P0_END = CV_NST - CV_G1 - CV_G3, CV_G1_END = CV_P0_END + CV_G1;
DEVI void convert_tiles(const Params& p, unsigned char* lds, int first, int stride, int end) {
    const int lane = otid() & 63, wave = otid() >> 6;
    float* scr = (float*)(lds + wave * 16640);
    unsigned char* ws = p.ws;
    const int kq = wave & 3, nq = wave >> 2;
    auto decode = [&](int st, const float*& W, bf16_t*& WT, int& K, int& N, int& k0, int& n0) -> bool {
        if (st >= end) return false;
        int r = st;
        if (r < CV_S0) { W = p.in[6]; WT = (bf16_t*)(ws + WS_WT_INA); K = 2048; N = 6144; }
        else if ((r -= CV_S0) < CV_S1) { W = p.in[8]; WT = (bf16_t*)(ws + WS_WT_OUTA); K = 2048; N = 2048; }
        else if ((r -= CV_S1) < CV_S2) { W = p.in[17]; WT = (bf16_t*)(ws + WS_WT_UP0); K = 2048; N = 8192; }
        else if ((r -= CV_S2) < CV_S3) { W = p.in[18]; WT = (bf16_t*)(ws + WS_WT_DN0); K = 8192; N = 2048; }
        else if ((r -= CV_S3) < CV_S4) { W = p.in[10]; WT = (bf16_t*)(ws + WS_WT_INB); K = 2048; N = NPROJ; }
        else if ((r -= CV_S4) < CV_S5) { W = p.in[15]; WT = (bf16_t*)(ws + WS_WT_OUTB); K = 4096; N = 2048; }
        else if ((r -= CV_S5) < CV_S2) { W = p.in[17] + (size_t)2048 * 8192; WT = (bf16_t*)(ws + WS_WT_UP1); K = 2048; N = 8192; }
        else { r -= CV_S2; W = p.in[18] + (size_t)8192 * 2048; WT = (bf16_t*)(ws + WS_WT_DN1); K = 8192; N = 2048; }
        const int nsb = (N + 127) / 128, KB = r / nsb, NB = r - KB * nsb;
        k0 = 256 * KB + 64 * kq; n0 = 128 * NB + 64 * nq;
        return n0 < N;
    };
    for (int st = first; st < end; st += 2 * stride) {
        const float *Wa = nullptr, *Wb = nullptr; bf16_t *WTa = nullptr, *WTb = nullptr; int Ka = 0, Na = 0, ka = 0, na = 0, Kb = 0, Nb = 0, kb = 0, nb2 = 0;
        const bool va = decode(st, Wa, WTa, Ka, Na, ka, na), vb = decode(st + stride, Wb, WTb, Kb, Nb, kb, nb2);
        f32x4 ta[16], tb[16];
        if (va) transpose_load(Wa, Na, ka, na, lane, ta);
        if (vb) transpose_load(Wb, Nb, kb, nb2, lane, tb);
        if (va) transpose_store(ta, Ka, WTa, scr, ka, na, lane);
        if (vb) transpose_store(tb, Kb, WTb, scr, kb, nb2, lane);
    }
}
DEVI void phase0(const Params& p, unsigned char* lds, int bid, int nb) {
    const int lane = otid() & 63, wave = otid() >> 6;
    const int gw = bid * 8 + wave, NGW = nb * 8;
    unsigned char* ws = p.ws;
    convert_tiles(p, lds, bid, nb, nb == 256 ? CV_P0_END : CV_NST);
    bf16_t* H = (bf16_t*)(ws + WS_H);
    f32x4 ww[8];
#pragma unroll
    for (int j = 0; j < 8; ++j) ww[j] = ((const f32x4*)p.in[5])[lane + 64 * j];
    auto finish = [&](f32x4 (&v)[8], bf16_t* o) { float s = 0.f;
#pragma unroll
        for (int j = 0; j < 8; ++j) s += (v[j].x * v[j].x + v[j].y * v[j].y) + (v[j].z * v[j].z + v[j].w * v[j].w);
        const float r = rsqrtf(wave_sum(s) * (1.f / D) + EPS);
#pragma unroll
        for (int j = 0; j < 8; ++j) { const unsigned lo = pk2(v[j].x * r * ww[j].x, v[j].y * r * ww[j].y), hi = pk2(v[j].z * r * ww[j].z, v[j].w * r * ww[j].w);
            ((unsigned long long*)o)[lane + 64 * j] = (unsigned long long)lo | ((unsigned long long)hi << 32); } };
    for (int row = gw; row < T; row += 2 * NGW) {
        const int row2 = row + NGW; const bool has2 = row2 < T;
        const float* srcA = row < TP ? p.in[0] + (size_t)row * D : p.in[1] + (size_t)(row - TP) * D;
        const float* srcB = row2 < TP ? p.in[0] + (size_t)row2 * D : p.in[1] + (size_t)(row2 - TP) * D;
        f32x4 va[8], vb[8];
#pragma unroll
        for (int j = 0; j < 8; ++j) va[j] = ((const f32x4*)srcA)[lane + 64 * j];
        if (has2) {
#pragma unroll
            for (int j = 0; j < 8; ++j) vb[j] = ((const f32x4*)srcB)[lane + 64 * j]; }
        finish(va, H + (size_t)row * D);
        if (has2) finish(vb, H + (size_t)row2 * D);
    }
}
DEVI void rms2_load(const float* xr, const bf16_t* pa, const bf16_t* pb, int pm, int lane, f32x4 (&v)[8], unsigned long long (&ra)[8], unsigned long long (&rb)[8]) {
#pragma unroll
    for (int j = 0; j < 8; ++j) { v[j] = ((const f32x4*)xr)[lane + 64 * j]; ra[j] = ((const unsigned long long*)pa)[lane + 64 * j]; rb[j] = sk_has_pb(pm, j) ? ((const unsigned long long*)pb)[lane + 64 * j] : 0ull; }
}
DEVI f32x4 unpk4(unsigned long long r) { return (f32x4){__uint_as_float((unsigned)r << 16), __uint_as_float((unsigned)r & 0xffff0000u), __uint_as_float((unsigned)(r >> 32) << 16), __uint_as_float((unsigned)(r >> 32) & 0xffff0000u)}; }
DEVI void rms2_finish(f32x4 (&v)[8], const unsigned long long (&ra)[8], const unsigned long long (&rb)[8], const f32x4 (&ww)[8], float* xcopy, bf16_t* o, int lane) {
    float s = 0.f;
#pragma unroll
    for (int j = 0; j < 8; ++j) { v[j] = v[j] + (unpk4(ra[j]) + unpk4(rb[j])); s += (v[j].x * v[j].x + v[j].y * v[j].y) + (v[j].z * v[j].z + v[j].w * v[j].w); }
    const float r = rsqrtf(wave_sum(s) * (1.f / D) + EPS);
#pragma unroll
    for (int j = 0; j < 8; ++j) { ((f32x4*)xcopy)[lane + 64 * j] = v[j];
        const unsigned lo = pk2(v[j].x * r * ww[j].x, v[j].y * r * ww[j].y), hi = pk2(v[j].z * r * ww[j].z, v[j].w * r * ww[j].w);
        ((unsigned long long*)o)[lane + 64 * j] = (unsigned long long)lo | ((unsigned long long)hi << 32); }
}
DEVI void phase_rms(const Params& p, const float* w, int bid, int nb, bool first) {
    const int lane = otid() & 63, wave = otid() >> 6;
    float* X = (float*)(p.ws + WS_X); bf16_t* H = (bf16_t*)(p.ws + WS_H); const bf16_t* PA = (const bf16_t*)(p.ws + WS_PA); const bf16_t* PB = (const bf16_t*)(p.ws + WS_PB);
    f32x4 ww[8];
#pragma unroll
    for (int j = 0; j < 8; ++j) ww[j] = ((const f32x4*)w)[lane + 64 * j];
    const int NGW = nb * 8;
    for (int row = bid * 8 + wave; row < T; row += 2 * NGW) {
        const int row2 = row + NGW; const bool has2 = row2 < T;
        const float* srcA = first ? (row < TP ? p.in[0] + (size_t)row * D : p.in[1] + (size_t)(row - TP) * D) : X + (size_t)row * D;
        f32x4 va[8], vb[8]; unsigned long long aa[8], ab[8], ba[8], bb[8];
        rms2_load(srcA, PA + (size_t)row * D, PB + (size_t)row * D, row >> 8, lane, va, aa, ab);
        if (has2) { const float* srcB = first ? (row2 < TP ? p.in[0] + (size_t)row2 * D : p.in[1] + (size_t)(row2 - TP) * D) : X + (size_t)row2 * D;
            rms2_load(srcB, PA + (size_t)row2 * D, PB + (size_t)row2 * D, row2 >> 8, lane, vb, ba, bb); }
        rms2_finish(va, aa, ab, ww, X + (size_t)row * D, H + (size_t)row * D, lane);
        if (has2) rms2_finish(vb, ba, bb, ww, X + (size_t)row2 * D, H + (size_t)row2 * D, lane);
    }
}
DEVI void rms2_finish_f32(f32x4 (&v)[8], const unsigned long long (&ra)[8], const unsigned long long (&rb)[8], const f32x4 (&ww)[8], float* o, int lane) {
    float s = 0.f;
#pragma unroll
    for (int j = 0; j < 8; ++j) { v[j] = v[j] + (unpk4(ra[j]) + unpk4(rb[j])); s += (v[j].x * v[j].x + v[j].y * v[j].y) + (v[j].z * v[j].z + v[j].w * v[j].w); }
    const float r = rsqrtf(wave_sum(s) * (1.f / D) + EPS);
#pragma unroll
    for (int j = 0; j < 8; ++j) ((f32x4*)o)[lane + 64 * j] = (f32x4){v[j].x * r * ww[j].x, v[j].y * r * ww[j].y, v[j].z * r * ww[j].z, v[j].w * r * ww[j].w};
}
DEVI void phase_rms_final(const Params& p, int bid, int nb) {
    const int lane = otid() & 63, wave = otid() >> 6;
    const float* X = (const float*)(p.ws + WS_X); const bf16_t* PA = (const bf16_t*)(p.ws + WS_PA); const bf16_t* PB = (const bf16_t*)(p.ws + WS_PB);
    f32x4 ww[8];
#pragma unroll
    for (int j = 0; j < 8; ++j) ww[j] = ((const f32x4*)p.in[19])[lane + 64 * j];
    const int NGW = nb * 8;
    for (int row = bid * 8 + wave; row < T; row += 2 * NGW) {
        const int row2 = row + NGW; const bool has2 = row2 < T;
        f32x4 va[8], vb[8]; unsigned long long aa[8], ab[8], ba[8], bb[8];
        rms2_load(X + (size_t)row * D, PA + (size_t)row * D, PB + (size_t)row * D, row >> 8, lane, va, aa, ab);
        if (has2) rms2_load(X + (size_t)row2 * D, PA + (size_t)row2 * D, PB + (size_t)row2 * D, row2 >> 8, lane, vb, ba, bb);
        rms2_finish_f32(va, aa, ab, ww, p.out + O_YP + (size_t)row * D, lane);
        if (has2) rms2_finish_f32(vb, ba, bb, ww, p.out + O_YP + (size_t)row2 * D, lane);
    }
}

DEVI void phase_conv_a(const Params& p, int bid, int nb) {
    const bf16_t* P1 = (const bf16_t*)(p.ws + WS_ACT); bf16_t* GBp = (bf16_t*)(p.ws + WS_GB);
    const float* wcv = p.in[7]; const float* st = p.in[2];
    const int idx0 = bid * 512 + otid(), NT = nb * 512, c0 = (idx0 & 255) * 8;
    float w0[8], w1[8], w2[8]; ld8f(wcv + c0, w0); ld8f(wcv + 2048 + c0, w1); ld8f(wcv + 4096 + c0, w2);
    auto geom = [&](int idx, int& t, bool& smp, int& b, int& pos, int& L) { t = idx >> 8; smp = t >= TP; if (!smp) { b = t >> 11; pos = t & 2047; L = 2048; } else { const int s = t - TP; b = s >> 3; pos = s & 7; L = 8; } };
    auto load = [&](int idx, u32x4 (&r0)[3], u32x4 (&r1)[2], u32x4 (&r2)[2]) {
        int t, b, pos, L; bool smp; geom(idx, t, smp, b, pos, L);
        const bf16_t* row = P1 + (size_t)t * 6144 + c0;
        r0[0] = *(const u32x4*)(row); r0[1] = *(const u32x4*)(row + 2048); r0[2] = *(const u32x4*)(row + 4096);
        if (pos >= 1) { r1[0] = *(const u32x4*)(row - 6144 + 2048); r1[1] = *(const u32x4*)(row - 6144 + 4096); }
        else if (smp) { const float* s1 = st + (size_t)(b * 2 + 1) * 2048 + c0; r1[0] = *(const u32x4*)(s1); r1[1] = *(const u32x4*)(s1 + 4); }
        else { r1[0] = (u32x4){0u, 0u, 0u, 0u}; r1[1] = r1[0]; }
        if (pos >= 2) { r2[0] = *(const u32x4*)(row - 2 * 6144 + 2048); r2[1] = *(const u32x4*)(row - 2 * 6144 + 4096); }
        else if (smp) { const float* s2 = st + (size_t)(b * 2 + pos) * 2048 + c0; r2[0] = *(const u32x4*)(s2); r2[1] = *(const u32x4*)(s2 + 4); }
        else { r2[0] = (u32x4){0u, 0u, 0u, 0u}; r2[1] = r2[0]; }
    };
    auto decode = [&](const u32x4 (&r)[2], bool from_rows, float (&u)[8]) {
        if (from_rows) { float cc[8], xx[8]; unpack8(r[0], cc); unpack8(r[1], xx);
#pragma unroll
            for (int i = 0; i < 8; ++i) u[i] = cc[i] * xx[i]; }
        else { u[0] = __uint_as_float(r[0].x); u[1] = __uint_as_float(r[0].y); u[2] = __uint_as_float(r[0].z); u[3] = __uint_as_float(r[0].w);
               u[4] = __uint_as_float(r[1].x); u[5] = __uint_as_float(r[1].y); u[6] = __uint_as_float(r[1].z); u[7] = __uint_as_float(r[1].w); }
    };
    auto finish = [&](int idx, const u32x4 (&r0)[3], const u32x4 (&r1)[2], const u32x4 (&r2)[2]) {
        int t, b, pos, L; bool smp; geom(idx, t, smp, b, pos, L);
        float gb[8], u0[8], u1[8], u2[8];
        unpack8(r0[0], gb); { const u32x4 cx[2] = {r0[1], r0[2]}; decode(cx, true, u0); }
        decode(r1, pos >= 1, u1); decode(r2, pos >= 2, u2);
        float g[8];
#pragma unroll
        for (int i = 0; i < 8; ++i) g[i] = gb[i] * (w0[i] * u2[i] + w1[i] * u1[i] + w2[i] * u0[i]);
        *(u32x4*)(GBp + (size_t)t * 2048 + c0) = pack8(g);
        if (pos >= L - 2) { float* o = p.out + (smp ? O_CAS : O_CAP) + (size_t)(b * 2 + (pos - (L - 2))) * 2048 + c0; st8f(o, u0); }
    };
    for (int idx = idx0; idx < T * 256; idx += 2 * NT) {
        const int idxB = idx + NT; const bool hasB = idxB < T * 256;
        u32x4 a0[3], a1[2], a2[2], b0[3], b1[2], b2[2];
        load(idx, a0, a1, a2);
        if (hasB) load(idxB, b0, b1, b2);
        finish(idx, a0, a1, a2);
        if (hasB) finish(idxB, b0, b1, b2);
    }
}

DEVI void phase_g1(const Params& p, int bid, int nb) {
    unsigned char* ws = p.ws;
    const bf16_t* QKV = (const bf16_t*)(ws + WS_QKV);
    bf16_t* QN = (bf16_t*)(ws + WS_QN); bf16_t* KN = (bf16_t*)(ws + WS_KN); bf16_t* VS = (bf16_t*)(ws + WS_VS);
    bf16_t* KT = (bf16_t*)(ws + WS_KT); bf16_t* VT = (bf16_t*)(ws + WS_VT);
    const float* wcv = p.in[11]; const float* st = p.in[3];
    const int g1lane = otid() & 63, g1wave = otid() >> 6;
    const int ch0 = ((bid * 8 + g1wave) & 63) * 128 + (g1lane >> 2) * 8;
    float w0[8], w1[8], w2[8], w3[8]; ld8f(wcv + ch0, w0); ld8f(wcv + 8192 + ch0, w1); ld8f(wcv + 2 * 8192 + ch0, w2); ld8f(wcv + 3 * 8192 + ch0, w3);
    for (int wi = bid * 8 + g1wave; wi < (T / 32) * 64; wi += nb * 8) {
        const int t0 = (wi >> 6) * 32 + (g1lane & 3) * 8;
        const bool smp = t0 >= TP; int b, pos0;
        if (!smp) { b = t0 >> 11; pos0 = t0 & 2047; } else { b = (t0 - TP) >> 3; pos0 = 0; }
        float h0[8], h1[8], h2[8];
        if (pos0 > 0) { const bf16_t* r = QKV + (size_t)t0 * 8192 + ch0; unpack8(*(const u32x4*)(r - 3 * 8192), h0); unpack8(*(const u32x4*)(r - 2 * 8192), h1); unpack8(*(const u32x4*)(r - 8192), h2); }
        else if (smp) { const float* r = st + (size_t)b * 3 * 8192 + ch0; ld8f(r, h0); ld8f(r + 8192, h1); ld8f(r + 2 * 8192, h2); }
        else {
#pragma unroll
            for (int i = 0; i < 8; ++i) { h0[i] = 0.f; h1[i] = 0.f; h2[i] = 0.f; } }
        float y[8][8];
        const bool tailp = (!smp) && (pos0 == 2040);
        u32x4 xraw[8];
#pragma unroll
        for (int i = 0; i < 8; ++i) xraw[i] = *(const u32x4*)(QKV + (size_t)(t0 + i) * 8192 + ch0);
#pragma unroll
        for (int i = 0; i < 8; ++i) {
            float x[8]; unpack8(xraw[i], x);
#pragma unroll
            for (int c = 0; c < 8; ++c) { const float a = w0[c] * h0[c] + w1[c] * h1[c] + w2[c] * h2[c] + w3[c] * x[c]; y[i][c] = silu_f(a); h0[c] = h1[c]; h1[c] = h2[c]; h2[c] = x[c]; }
            if (i >= 5 && (smp || tailp)) { float* o = p.out + (smp ? O_CBS : O_CBP) + (size_t)(b * 3 + (i - 5)) * 8192 + ch0; st8f(o, x); }
        }
        if (ch0 < 4096) {
            const float sc = ch0 < 2048 ? 0.08838834764831845f : 1.f;
#pragma unroll
            for (int i = 0; i < 8; ++i) { float s = 0.f;
#pragma unroll
                for (int c = 0; c < 8; ++c) s += y[i][c] * y[i][c];
                s += __shfl_xor(s, 4); s += __shfl_xor(s, 8); s += __shfl_xor(s, 16); s += __shfl_xor(s, 32);
                const float r = rsqrtf(s + EPS) * sc;
#pragma unroll
                for (int c = 0; c < 8; ++c) y[i][c] *= r; }
        }
        if (ch0 < 2048) {
#pragma unroll
            for (int i = 0; i < 8; ++i) *(u32x4*)(QN + (size_t)(t0 + i) * 2048 + ch0) = pack8(y[i]);
        } else if (ch0 < 4096) {
            const int ck = ch0 - 2048;
#pragma unroll
            for (int i = 0; i < 8; ++i) *(u32x4*)(KN + (size_t)(t0 + i) * 2048 + ck) = pack8(y[i]);
            if (!smp) { const int n = pos0 >> 6, j0 = pos0 & 63, hk = ck >> 7, d0 = ck & 127;
                bf16_t* base = KT + ((size_t)((b * 32 + n) * 16 + hk) * 128 + d0) * 64 + j0;
#pragma unroll
                for (int c = 0; c < 8; ++c) { u32x4 w; w.x = pk2(y[0][c], y[1][c]); w.y = pk2(y[2][c], y[3][c]); w.z = pk2(y[4][c], y[5][c]); w.w = pk2(y[6][c], y[7][c]); *(u32x4*)(base + c * 64) = w; } }
        } else {
            const int cv = ch0 - 4096;
            if (smp) {
#pragma unroll
                for (int i = 0; i < 8; ++i) *(u32x4*)(VS + (size_t)(t0 - TP + i) * 4096 + cv) = pack8(y[i]);
            } else { const int n = pos0 >> 6, j0 = pos0 & 63, hv = cv >> 7, e0 = cv & 127;
                bf16_t* base = VT + ((size_t)((b * 32 + n) * 32 + hv) * 128 + e0) * 64 + j0;
#pragma unroll
                for (int c = 0; c < 8; ++c) { u32x4 w; w.x = pk2(y[0][c], y[1][c]); w.y = pk2(y[2][c], y[3][c]); w.z = pk2(y[4][c], y[5][c]); w.w = pk2(y[6][c], y[7][c]); *(u32x4*)(base + c * 64) = w; } }
        }
    }
    const float* BA = (const float*)(ws + WS_BA); float* BETA = (float*)(ws + WS_BETA); float* GG = (float*)(ws + WS_GG);
    for (int idx = bid * 512 + otid(); idx < T * 32; idx += nb * 512) {
        const int t = idx >> 5, h = idx & 31;
        const float br = BA[(size_t)t * 64 + h], ar = BA[(size_t)t * 64 + 32 + h];
        BETA[idx] = 1.f / (1.f + expf(-br));
        const float xs = ar + p.in[13][h];
        const float sp = fmaxf(xs, 0.f) + log1pf(expf(-fabsf(xs)));
        GG[idx] = -expf(p.in[12][h]) * sp;
    }
}

DEVI void phase_g2(const Params& p, unsigned char* lds, int bid, int nb) {
    unsigned char* ws = p.ws;
    const int lane0 = otid() & 63, wave = otid() >> 6;
    float* Am = (float*)(lds + wave * 16384);
    const bf16_t* QN = (const bf16_t*)(ws + WS_QN); const bf16_t* KN = (const bf16_t*)(ws + WS_KN);
    const bf16_t* KT = (const bf16_t*)(ws + WS_KT); const bf16_t* VT = (const bf16_t*)(ws + WS_VT);
    const float* BETA = (const float*)(ws + WS_BETA); const float* GG = (const float*)(ws + WS_GG); float* GC = (float*)(ws + WS_GC);
    bf16_t* UT = (bf16_t*)(ws + WS_UT); bf16_t* WW = (bf16_t*)(ws + WS_WW); bf16_t* QKM = (bf16_t*)(ws + WS_QKM);
    for (int it = bid * 8 + wave; it < 4096; it += nb * 8) {
        int lane = lane0; asm volatile("" : "+v"(lane));
        const int fr = lane & 15, fq = lane >> 4;
        const int b = it >> 10, n = (it >> 5) & 31, h = it & 31, hk = h >> 1, t0 = b * 2048 + n * 64;
        const size_t itemK = (size_t)((b * 32 + n) * 16 + hk);
        float gc = GG[(size_t)(t0 + lane) * 32 + h]; const float bt = BETA[(size_t)(t0 + lane) * 32 + h];
#pragma unroll
        for (int o = 1; o < 64; o <<= 1) { const float v = __shfl_up(gc, o); if (lane >= o) gc += v; }
        GC[(size_t)(t0 + lane) * 32 + h] = gc;
        const bf16_t* kbase = KN + (size_t)(t0 + fr) * 2048 + hk * 128 + 8 * fq;
        const bf16_t* qbase = QN + (size_t)(t0 + fr) * 2048 + hk * 128 + 8 * fq;
        {
            bf16x8 kf[4][4], qf[2][4];
#pragma unroll
            for (int m = 0; m < 4; ++m)
#pragma unroll
                for (int kk = 0; kk < 4; ++kk) kf[m][kk] = ldfrag(kbase + (size_t)(16 * m) * 2048 + 32 * kk);
#pragma unroll
            for (int m = 0; m < 4; ++m)
#pragma unroll
                for (int nn = 0; nn < 4; ++nn) {
                    f32x4 acc = {0.f, 0.f, 0.f, 0.f};
                    if (nn <= m) {
#pragma unroll
                        for (int kk = 0; kk < 4; ++kk) acc = mfma16(kf[m][kk], kf[nn][kk], acc); }
                    const int j = 16 * nn + fr; const float gj = __shfl(gc, j);
#pragma unroll
                    for (int jj = 0; jj < 4; ++jj) { const int i = 16 * m + 4 * fq + jj; const float gi = __shfl(gc, i), bi = __shfl(bt, i);
                        Am[i * 64 + j] = (i > j) ? -(bi * acc[jj] * __expf(gi - gj)) : 0.f; }
                }
            bf16_t* qkb = QKM + (size_t)it * 4096;
#pragma unroll
            for (int ni = 0; ni < 4; ++ni) { const int i = 16 * ni + fr; const float gi = __shfl(gc, i);
                if ((ni & 1) == 0) {
#pragma unroll
                    for (int m = 0; m < 2; ++m)
#pragma unroll
                        for (int kk = 0; kk < 4; ++kk) qf[m][kk] = ldfrag(qbase + (size_t)(16 * (ni + m)) * 2048 + 32 * kk); }
#pragma unroll
                for (int mj = 0; mj < 4; ++mj) {
                    f32x4 acc = {0.f, 0.f, 0.f, 0.f};
                    if (ni >= mj) {
#pragma unroll
                        for (int kk = 0; kk < 4; ++kk) acc = mfma16(kf[mj][kk], qf[ni & 1][kk], acc); }
                    float o[4];
#pragma unroll
                    for (int jj = 0; jj < 4; ++jj) { const int j = 16 * mj + 4 * fq + jj; const float gj = __shfl(gc, j); o[jj] = (i >= j) ? acc[jj] * __expf(gi - gj) : 0.f; }
                    *(unsigned long long*)(qkb + (size_t)i * 64 + 16 * mj + 4 * fq) = (unsigned long long)pk2(o[0], o[1]) | ((unsigned long long)pk2(o[2], o[3]) << 32);
                } }
        }
        WAVE_LDS_SYNC();
        bf16x8 vfr[8][2];
        { const bf16_t* vtb = VT + (size_t)it * 8192 + (size_t)fr * 64 + 8 * fq;
#pragma unroll
          for (int t8 = 0; t8 < 8; ++t8) { vfr[t8][0] = ldfrag(vtb + t8 * 1024); vfr[t8][1] = ldfrag(vtb + t8 * 1024 + 32); } }
        {
            float a[64];
#pragma unroll
            for (int i = 0; i < 64; ++i) a[i] = Am[i * 64 + lane];
            typedef float f32x2_t __attribute__((ext_vector_type(2)));
#pragma unroll
            for (int i = 2; i < 64; ++i) {
                const int rb = __float_as_int(a[i]); f32x2_t acc = {a[i], 0.f};
#pragma unroll
                for (int j = 1; j + 1 < i; j += 2) { const f32x2_t s = {__int_as_float(__builtin_amdgcn_readlane(rb, j)), __int_as_float(__builtin_amdgcn_readlane(rb, j + 1))};
                    const f32x2_t av = {a[j], a[j + 1]}; acc = __builtin_elementwise_fma(s, av, acc); }
                float r = acc.x + acc.y;
                if (((i - 1) & 1) != 0) r += __int_as_float(__builtin_amdgcn_readlane(rb, i - 1)) * a[i - 1];
                a[i] = r;
            }
#pragma unroll
            for (int i = 2; i < 64; ++i) Am[i * 64 + lane] = a[i];
        }
        WAVE_LDS_SYNC();
        {
            bf16x8 tp[4][2], tpp[4][2];
#pragma unroll
            for (int kk = 0; kk < 2; ++kk) {
                float bj[8], bg[8];
#pragma unroll
                for (int s = 0; s < 8; ++s) { const int j = 32 * kk + 8 * fq + s; bj[s] = __shfl(bt, j); bg[s] = bj[s] * __expf(__shfl(gc, j)); }
#pragma unroll
                for (int mi = 0; mi < 4; ++mi) { const int i = 16 * mi + fr; float tv[8]; ld8f(Am + i * 64 + 32 * kk + 8 * fq, tv);
                    float a[8], c[8];
#pragma unroll
                    for (int s = 0; s < 8; ++s) { const float t = tv[s] + ((i == 32 * kk + 8 * fq + s) ? 1.f : 0.f); a[s] = t * bj[s]; c[s] = t * bg[s]; }
                    const u32x4 pa = pack8(a), pc = pack8(c); tp[mi][kk] = __builtin_bit_cast(bf16x8, pa); tpp[mi][kk] = __builtin_bit_cast(bf16x8, pc); }
            }
            bf16_t* utb = UT + (size_t)it * 8192; bf16_t* stg = (bf16_t*)Am;
            WAVE_LDS_SYNC();
#pragma unroll
            for (int ne = 0; ne < 8; ++ne) {
#pragma unroll
                for (int mi = 0; mi < 4; ++mi) { f32x4 acc = {0.f, 0.f, 0.f, 0.f}; acc = mfma16(tp[mi][0], vfr[ne][0], acc); acc = mfma16(tp[mi][1], vfr[ne][1], acc);
                    *(unsigned long long*)(stg + (16 * ne + fr) * 64 + 16 * mi + 4 * fq) = (unsigned long long)pk2(acc[0], acc[1]) | ((unsigned long long)pk2(acc[2], acc[3]) << 32); } }
            WAVE_LDS_SYNC();
            { u32x4 tv[16];
#pragma unroll
              for (int q = 0; q < 16; ++q) tv[q] = *(const u32x4*)(stg + q * 512 + lane * 8);
#pragma unroll
              for (int q = 0; q < 16; ++q) *(u32x4*)(utb + q * 512 + lane * 8) = tv[q]; }
            WAVE_LDS_SYNC();
            bf16x8 kfr[8][2];
            { const bf16_t* ktb = KT + itemK * 8192 + (size_t)fr * 64 + 8 * fq;
#pragma unroll
              for (int t8 = 0; t8 < 8; ++t8) { kfr[t8][0] = ldfrag(ktb + t8 * 1024); kfr[t8][1] = ldfrag(ktb + t8 * 1024 + 32); } }
            bf16_t* wwb = WW + (size_t)it * 8192;
#pragma unroll
            for (int md = 0; md < 8; ++md) {
#pragma unroll
                for (int ni = 0; ni < 4; ++ni) { f32x4 acc = {0.f, 0.f, 0.f, 0.f}; acc = mfma16(kfr[md][0], tpp[ni][0], acc); acc = mfma16(kfr[md][1], tpp[ni][1], acc);
                    *(unsigned long long*)(stg + (16 * ni + fr) * 128 + 16 * md + 4 * fq) = (unsigned long long)pk2(acc[0], acc[1]) | ((unsigned long long)pk2(acc[2], acc[3]) << 32); } }
            WAVE_LDS_SYNC();
            { u32x4 tv[16];
#pragma unroll
              for (int q = 0; q < 16; ++q) tv[q] = *(const u32x4*)(stg + q * 512 + lane * 8);
#pragma unroll
              for (int q = 0; q < 16; ++q) *(u32x4*)(wwb + q * 512 + lane * 8) = tv[q]; }
        }
        WAVE_LDS_SYNC();
    }
}

template <bool DIAG> DEVI void g3_chain(const Params& p, unsigned char* lds, int item_bh) {
    unsigned char* ws = p.ws;
    const int tid = otid(), lane = tid & 63, w = tid >> 6, fr = lane & 15, fq = lane >> 4;
    const int b = item_bh >> 5, h = item_bh & 31, hk = h >> 1, m = w & 3, eh = w >> 2;
    bf16_t* St = (bf16_t*)lds; bf16_t* VNT = (bf16_t*)(lds + 34816); bf16_t* VNS = (bf16_t*)(lds + 34816 + 18432); float* RED = (float*)(lds + 34816 + 2 * 18432);
    const bf16_t* QN = (const bf16_t*)(ws + WS_QN); const bf16_t* KT = (const bf16_t*)(ws + WS_KT);
    const bf16_t* UT = (const bf16_t*)(ws + WS_UT); const bf16_t* WW = (const bf16_t*)(ws + WS_WW); const bf16_t* QKM = (const bf16_t*)(ws + WS_QKM);
    const float* GC = (const float*)(ws + WS_GC); const bf16_t* Z = (const bf16_t*)(ws + WS_Z); bf16_t* OG = (bf16_t*)(ws + WS_OG);
    const float* onorm = p.in[14];
    f32x4 s[2][4];
#pragma unroll
    for (int a = 0; a < 2; ++a)
#pragma unroll
        for (int c = 0; c < 4; ++c) { s[a][c] = (f32x4){0.f, 0.f, 0.f, 0.f};
            *(unsigned long long*)(St + (size_t)(16 * (4 * eh + c) + fr) * 136 + 16 * (2 * m + a) + 4 * fq) = 0ull; }
    LDS_BARRIER();
    float on[4];
#pragma unroll
    for (int ne = 0; ne < 4; ++ne) on[ne] = onorm[16 * (4 * eh + ne) + fr];
    bf16x8 wf[4], qf[4], qkf[2], ktf[2][2]; float gi[4], gl;
    bf16x8 nwf[4], nqf[4], nqkf[2], nktf[2][2]; float ngi[4], ngl;
    PG8_LAS unsigned char* dma = (PG8_LAS unsigned char*)lds + 73728 + w * 8192;
#define CHAIN_LOAD_A(WF, QF, QKF, KTF, GI, GL, n_) do { \
        const size_t item_ = (size_t)((b * 32 + (n_)) * 32 + h), itemK_ = (size_t)((b * 32 + (n_)) * 16 + hk); const int t0_ = b * 2048 + (n_) * 64; \
        _Pragma("unroll") for (int k2 = 0; k2 < 2; ++k2) { QKF[k2] = ldfrag(QKM + item_ * 4096 + (size_t)(16 * m + fr) * 64 + 32 * k2 + 8 * fq); \
            _Pragma("unroll") for (int a = 0; a < 2; ++a) KTF[a][k2] = ldfrag(KT + itemK_ * 8192 + (size_t)(16 * (2 * m + a) + fr) * 64 + 32 * k2 + 8 * fq); } \
        _Pragma("unroll") for (int kk = 0; kk < 4; ++kk) { WF[kk] = ldfrag(WW + item_ * 8192 + (size_t)(16 * m + fr) * 128 + 32 * kk + 8 * fq); QF[kk] = ldfrag(QN + (size_t)(t0_ + 16 * m + fr) * 2048 + hk * 128 + 32 * kk + 8 * fq); } \
        _Pragma("unroll") for (int jj = 0; jj < 4; ++jj) GI[jj] = GC[(size_t)(t0_ + 16 * m + 4 * fq + jj) * 32 + h]; \
        GL = GC[(size_t)(t0_ + 63) * 32 + h]; } while (0)
#define CHAIN_DMA(n_, buf_) do { \
        const size_t item_ = (size_t)((b * 32 + (n_)) * 32 + h); const int t0_ = b * 2048 + (n_) * 64; \
        _Pragma("unroll") for (int q = 0; q < 2; ++q) { const int pi = q * 64 + lane; \
            __builtin_amdgcn_global_load_lds((const unsigned*)(UT + item_ * 8192 + (size_t)(64 * eh + (pi >> 1)) * 64 + 16 * m + 8 * (pi & 1)), (PG8_LAS unsigned*)(dma + (buf_) * 4096 + q * 1024), 16, 0, 0); \
            __builtin_amdgcn_global_load_lds((const unsigned*)(Z + (size_t)(t0_ + 16 * m + (pi >> 3)) * 4096 + h * 128 + 64 * eh + 8 * (pi & 7)), (PG8_LAS unsigned*)(dma + (buf_) * 4096 + 2048 + q * 1024), 16, 0, 0); } \
        asm volatile("" ::: "memory"); } while (0)
    if constexpr (!DIAG) CHAIN_DMA(0, 0);
    CHAIN_LOAD_A(wf, qf, qkf, ktf, gi, gl, 0);
    auto chain_body = [&](const int n, auto FIRST_, auto LAST_) {
        constexpr bool FIRST = decltype(FIRST_)::value, LAST = decltype(LAST_)::value;
        const int t0 = b * 2048 + n * 64;
        f32x4 P[4], O1[4];
#pragma unroll
        for (int ne = 0; ne < 4; ++ne) { P[ne] = (f32x4){0.f, 0.f, 0.f, 0.f}; O1[ne] = (f32x4){0.f, 0.f, 0.f, 0.f};
#pragma unroll
            for (int kk = 0; kk < 4; ++kk) { const bf16x8 bf = ldfrag(St + (size_t)(16 * (4 * eh + ne) + fr) * 136 + 32 * kk + 8 * fq); P[ne] = mfma16(wf[kk], bf, P[ne]); O1[ne] = mfma16(qf[kk], bf, O1[ne]); } }
        if constexpr (!LAST && !DIAG) CHAIN_DMA(n + 1, (n + 1) & 1);
        if constexpr (!LAST && !DIAG) CHAIN_LOAD_A(nwf, nqf, nqkf, nktf, ngi, ngl, n + 1);
        unsigned long long ut[4];
#pragma unroll
        for (int ne = 0; ne < 4; ++ne) ut[ne] = *(const PG8_LAS unsigned long long*)(dma + (n & 1) * 4096 + ((16 * ne + fr) * 2 + (fq >> 1)) * 16 + (fq & 1) * 8);
        float eg[4], ed[4];
#pragma unroll
        for (int jj = 0; jj < 4; ++jj) { eg[jj] = __expf(gi[jj]); ed[jj] = __expf(gl - gi[jj]); }
#pragma unroll
        for (int ne = 0; ne < 4; ++ne) { float vn[4];
            vn[0] = bf2f((unsigned short)(ut[ne] & 0xffffu)) - P[ne][0]; vn[1] = bf2f((unsigned short)((ut[ne] >> 16) & 0xffffu)) - P[ne][1];
            vn[2] = bf2f((unsigned short)((ut[ne] >> 32) & 0xffffu)) - P[ne][2]; vn[3] = bf2f((unsigned short)((ut[ne] >> 48) & 0xffffu)) - P[ne][3];
            const size_t off = (size_t)(16 * (4 * eh + ne) + fr) * 72 + 16 * m + 4 * fq;
            *(unsigned long long*)(VNT + off) = (unsigned long long)pk2(vn[0], vn[1]) | ((unsigned long long)pk2(vn[2], vn[3]) << 32);
            *(unsigned long long*)(VNS + off) = (unsigned long long)pk2(vn[0] * ed[0], vn[1] * ed[1]) | ((unsigned long long)pk2(vn[2] * ed[2], vn[3] * ed[3]) << 32);
#pragma unroll
            for (int jj = 0; jj < 4; ++jj) O1[ne][jj] *= eg[jj]; }
        LDS_BARRIER();
#pragma unroll
        for (int ne = 0; ne < 4; ++ne)
#pragma unroll
            for (int k2 = 0; k2 < 2; ++k2) { const bf16x8 bf = ldfrag(VNT + (size_t)(16 * (4 * eh + ne) + fr) * 72 + 32 * k2 + 8 * fq); O1[ne] = mfma16(qkf[k2], bf, O1[ne]); }
        float ss[4];
#pragma unroll
        for (int jj = 0; jj < 4; ++jj) { float v = O1[0][jj] * O1[0][jj] + O1[1][jj] * O1[1][jj] + O1[2][jj] * O1[2][jj] + O1[3][jj] * O1[3][jj];
            v += __shfl_xor(v, 1); v += __shfl_xor(v, 2); v += __shfl_xor(v, 4); v += __shfl_xor(v, 8); ss[jj] = v; }
        if (fr == 0) {
#pragma unroll
            for (int jj = 0; jj < 4; ++jj) RED[eh * 64 + 16 * m + 4 * fq + jj] = ss[jj]; }
        const float egl = __expf(gl);
#pragma unroll
        for (int a = 0; a < 2; ++a)
#pragma unroll
            for (int ne = 0; ne < 4; ++ne) { s[a][ne] = s[a][ne] * egl;
#pragma unroll
                for (int k2 = 0; k2 < 2; ++k2) { const bf16x8 bf = ldfrag(VNS + (size_t)(16 * (4 * eh + ne) + fr) * 72 + 32 * k2 + 8 * fq); s[a][ne] = mfma16(ktf[a][k2], bf, s[a][ne]); } }
        LDS_BARRIER();
#pragma unroll
        for (int a = 0; a < 2; ++a)
#pragma unroll
            for (int ne = 0; ne < 4; ++ne)
                *(unsigned long long*)(St + (size_t)(16 * (4 * eh + ne) + fr) * 136 + 16 * (2 * m + a) + 4 * fq) = (unsigned long long)pk2(s[a][ne][0], s[a][ne][1]) | ((unsigned long long)pk2(s[a][ne][2], s[a][ne][3]) << 32);
#pragma unroll
        for (int jj = 0; jj < 4; ++jj) { const int i = 16 * m + 4 * fq + jj; const float r = rsqrtf((RED[i] + RED[64 + i]) * (1.f / 128.f) + EPS);
            const size_t ro = (size_t)(t0 + i) * 4096 + h * 128;
#pragma unroll
            for (int ne = 0; ne < 4; ++ne) { const int e = 16 * (4 * eh + ne) + fr; const float z = bf2f(*(const PG8_LAS unsigned short*)(dma + (n & 1) * 4096 + 2048 + ((4 * fq + jj) * 8 + 2 * ne + (fr >> 3)) * 16 + (fr & 7) * 2));
                const unsigned short ov = f2bf(O1[ne][jj] * r * on[ne] * silu_f(z)); if constexpr (!DIAG) OG[ro + e] = ov; else asm volatile("" :: "v"((unsigned)ov)); } }
#pragma unroll
        for (int kk = 0; kk < 4; ++kk) { if constexpr (!DIAG) { wf[kk] = nwf[kk]; qf[kk] = nqf[kk]; gi[kk] = ngi[kk]; } }
        if constexpr (!DIAG) { gl = ngl; qkf[0] = nqkf[0]; qkf[1] = nqkf[1]; ktf[0][0] = nktf[0][0]; ktf[0][1] = nktf[0][1]; ktf[1][0] = nktf[1][0]; ktf[1][1] = nktf[1][1]; }
        LDS_BARRIER();
    };
    chain_body(0, std::true_type{}, std::false_type{});
#pragma unroll 1
    for (int n = 1; n < 31; ++n) chain_body(n, std::false_type{}, std::false_type{});
    chain_body(31, std::false_type{}, std::true_type{});
#undef CHAIN_LOAD_A
#undef CHAIN_DMA
    if constexpr (DIAG) { asm volatile("" :: "v"(s[0][0][0]), "v"(s[1][3][3])); return; }
    float* so = p.out + O_SSP + (size_t)item_bh * 16384;
#pragma unroll
    for (int a = 0; a < 2; ++a)
#pragma unroll
        for (int ne = 0; ne < 4; ++ne)
#pragma unroll
            for (int jj = 0; jj < 4; ++jj) so[(size_t)(16 * (2 * m + a) + 4 * fq + jj) * 128 + 16 * (4 * eh + ne) + fr] = s[a][ne][jj];
}

template <bool DIAG> DEVI void g3_sample(const Params& p, unsigned char* lds, int first, int stride, int end) {
    unsigned char* ws = p.ws;
    const int tid0 = otid();
    bf16_t* St = (bf16_t*)lds;
    constexpr int KS = 136;
    float* KF = (float*)(lds + 34816); float* QF = KF + 8 * KS; float* VF = QF + 8 * KS;
    float* SM = VF + 8 * KS;
    float* gcs = SM; float* bts = SM + 8; float* M1 = SM + 16; float* QKs = SM + 80; float* Tm = SM + 144;
    bf16_t* AW = (bf16_t*)(SM + 256);
    float* UF = (float*)((unsigned char*)AW + 16 * 136 * 2);
    bf16_t* KDT = (bf16_t*)(UF + 1024);
    bf16_t* VNT = KDT + 1024;
    float* RED = (float*)(VNT + 1024);
    float* WSQ = RED + 64;
    const bf16_t* QN = (const bf16_t*)(ws + WS_QN); const bf16_t* KN = (const bf16_t*)(ws + WS_KN); const bf16_t* VS = (const bf16_t*)(ws + WS_VS);
    const float* BETA = (const float*)(ws + WS_BETA); const float* GG = (const float*)(ws + WS_GG);
    const bf16_t* Z = (const bf16_t*)(ws + WS_Z); bf16_t* OG = (bf16_t*)(ws + WS_OG);
    const float* s0 = p.in[4]; const float* onorm = p.in[14];
    f32x4 sreg[8], snext[8];
    unsigned pk = 0, pq = 0, pv = 0, pz0 = 0, pz1 = 0; float pg = 0.f, pb = 0.f;
#define SAMPLE_PREFETCH(it_) do { const int bs_ = (it_) >> 5, h_ = (it_) & 31, hk_ = h_ >> 1, tS_ = TP + bs_ * 8; const int i_ = tid >> 6, d2_ = (tid & 63) * 2; \
        pk = *(const unsigned*)(KN + (size_t)(tS_ + i_) * 2048 + hk_ * 128 + d2_); pq = *(const unsigned*)(QN + (size_t)(tS_ + i_) * 2048 + hk_ * 128 + d2_); \
        pv = *(const unsigned*)(VS + (size_t)(bs_ * 8 + i_) * 4096 + h_ * 128 + d2_); \
        if (tid < 8) { pg = GG[(size_t)(tS_ + tid) * 32 + h_]; pb = BETA[(size_t)(tS_ + tid) * 32 + h_]; } \
        pz0 = Z[(size_t)(tS_ + 2 * fq) * 4096 + h_ * 128 + 16 * w + fr]; pz1 = Z[(size_t)(tS_ + 2 * fq + 1) * 4096 + h_ * 128 + 16 * w + fr]; } while (0)
    { const int tid = tid0, lane = tid & 63, w = tid >> 6, fr = lane & 15, fq = lane >> 4; (void)lane;
    if (first < end) {
#pragma unroll
        for (int mm = 0; mm < 8; ++mm) sreg[mm] = *(const f32x4*)(s0 + (size_t)first * 16384 + (size_t)(16 * mm + fr) * 128 + 16 * w + 4 * fq);
        SAMPLE_PREFETCH(first);
    }
    }
    auto sample_body = [&](const int it, auto FIRST_, auto LAST_) {
        constexpr bool FIRST = decltype(FIRST_)::value, LAST = decltype(LAST_)::value;
        int tid = tid0; asm volatile("" : "+v"(tid));
        const int lane = tid & 63, w = tid >> 6, fr = lane & 15, fq = lane >> 4;
        const int bs = it >> 5, h = it & 31, hk = h >> 1, tS = TP + bs * 8;
#pragma unroll
        for (int mm = 0; mm < 8; ++mm)
#pragma unroll
            for (int jj = 0; jj < 4; ++jj) St[(size_t)(16 * w + 4 * fq + jj) * 136 + 16 * mm + fr] = f2bf(sreg[mm][jj]);
        if constexpr (!LAST && !DIAG) {
#pragma unroll
            for (int mm = 0; mm < 8; ++mm) snext[mm] = *(const f32x4*)(s0 + (size_t)(it + stride) * 16384 + (size_t)(16 * mm + fr) * 128 + 16 * w + 4 * fq);
        }
        { const int i = tid >> 6, d2 = (tid & 63) * 2;
          KF[i * KS + d2] = __uint_as_float(pk << 16); KF[i * KS + d2 + 1] = __uint_as_float(pk & 0xffff0000u);
          QF[i * KS + d2] = __uint_as_float(pq << 16); QF[i * KS + d2 + 1] = __uint_as_float(pq & 0xffff0000u);
          VF[i * KS + d2] = __uint_as_float(pv << 16); VF[i * KS + d2 + 1] = __uint_as_float(pv & 0xffff0000u); }
        if (w == 0) { float g = (tid < 8) ? pg : 0.f;
#pragma unroll
            for (int o = 1; o < 8; o <<= 1) { const float v = __shfl_up(g, o); if (lane >= o) g += v; }
            if (tid < 8) { gcs[tid] = g; bts[tid] = pb; } }
        const float zc0 = __uint_as_float(pz0 << 16), zc1 = __uint_as_float(pz1 << 16);
        if constexpr (!LAST && !DIAG) SAMPLE_PREFETCH(it + stride);
        LDS_BARRIER();
        { const int pid = tid >> 3, i = pid >> 3, j = pid & 7, part = tid & 7; float kkv = 0.f, qkv = 0.f;
#pragma unroll
          for (int d = 0; d < 16; ++d) { const float kj = KF[j * KS + part + 8 * d]; kkv += KF[i * KS + part + 8 * d] * kj; qkv += QF[i * KS + part + 8 * d] * kj; }
          kkv += __shfl_xor(kkv, 1); kkv += __shfl_xor(kkv, 2); kkv += __shfl_xor(kkv, 4);
          qkv += __shfl_xor(qkv, 1); qkv += __shfl_xor(qkv, 2); qkv += __shfl_xor(qkv, 4);
          if (part == 0) { const float dg = gcs[i] - gcs[j]; const float e = (i >= j) ? __expf(dg) : 0.f;
              M1[i * 8 + j] = (i > j) ? bts[i] * kkv * e : 0.f; QKs[i * 8 + j] = qkv * e; } }
        LDS_BARRIER();
        if (tid < 8) { float x[8];
#pragma unroll
            for (int i = 0; i < 8; ++i) { float a = (i == tid) ? 1.f : 0.f;
#pragma unroll
                for (int j = 0; j < 8; ++j) if (j < i) a -= M1[i * 8 + j] * x[j];
                x[i] = a; Tm[i * 8 + tid] = a; } }
        LDS_BARRIER();
#pragma unroll
        for (int r = 0; r < 2; ++r) { const int idx = tid + 512 * r, i = idx >> 7, e = idx & 127; float a = 0.f, c = 0.f;
#pragma unroll
            for (int j = 0; j < 8; ++j) { const float tb = Tm[i * 8 + j] * bts[j]; a += tb * VF[j * KS + e]; c += tb * __expf(gcs[j]) * KF[j * KS + e]; }
            UF[idx] = a; AW[i * 136 + e] = f2bf(c); AW[(8 + i) * 136 + e] = f2bf(QF[i * KS + e]);
            KDT[e * 8 + i] = f2bf(KF[i * KS + e] * __expf(gcs[7] - gcs[i])); }
        LDS_BARRIER();
        { f32x4 acc = {0.f, 0.f, 0.f, 0.f};
#pragma unroll
          for (int kk = 0; kk < 4; ++kk) acc = mfma16(ldfrag(AW + fr * 136 + 32 * kk + 8 * fq), ldfrag(St + (size_t)(16 * w + fr) * 136 + 32 * kk + 8 * fq), acc);
#pragma unroll
          for (int jj = 0; jj < 4; ++jj) WSQ[(4 * fq + jj) * 128 + 16 * w + fr] = acc[jj]; }
        WAVE_LDS_SYNC();
        const int e = 16 * w + fr;
        float vn[8], o2[2];
#pragma unroll
        for (int j = 0; j < 8; ++j) vn[j] = UF[j * 128 + e] - WSQ[j * 128 + e];
        if (fq == 0) *(u32x4*)(VNT + e * 8) = pack8(vn);
#pragma unroll
        for (int r = 0; r < 2; ++r) { const int i = 2 * fq + r; float o = __expf(gcs[i]) * WSQ[(8 + i) * 128 + e];
#pragma unroll
            for (int j = 0; j < 8; ++j) o += QKs[i * 8 + j] * vn[j];
            o2[r] = o; float v = o * o; v += __shfl_xor(v, 1); v += __shfl_xor(v, 2); v += __shfl_xor(v, 4); v += __shfl_xor(v, 8);
            if (fr == 0) RED[w * 8 + i] = v; }
        LDS_BARRIER();
#pragma unroll
        for (int r = 0; r < 2; ++r) { const int i = 2 * fq + r; float tot = 0.f;
#pragma unroll
            for (int ww = 0; ww < 8; ++ww) tot += RED[ww * 8 + i];
            const float rr = rsqrtf(tot * (1.f / 128.f) + EPS); const float z = r ? zc1 : zc0;
            const unsigned short ov = f2bf(o2[r] * rr * onorm[e] * silu_f(z)); if constexpr (!DIAG) OG[(size_t)(tS + i) * 4096 + h * 128 + e] = ov; else asm volatile("" :: "v"((unsigned)ov)); }
        { const float egl = __expf(gcs[7]); bf16x8 af = {0, 0, 0, 0, 0, 0, 0, 0};
          if (fq == 0) af = ldfrag(VNT + (size_t)(16 * w + fr) * 8);
          float* so = p.out + O_SSS + (size_t)it * 16384;
#pragma unroll
          for (int mm = 0; mm < 8; ++mm) { bf16x8 bf = {0, 0, 0, 0, 0, 0, 0, 0}; if (fq == 0) bf = ldfrag(KDT + (size_t)(16 * mm + fr) * 8);
              f32x4 acc = sreg[mm] * egl; acc = mfma16(af, bf, acc);
              if constexpr (!DIAG) *(f32x4*)(so + (size_t)(16 * mm + fr) * 128 + 16 * w + 4 * fq) = acc; else asm volatile("" :: "v"(acc[0]), "v"(acc[3])); } }
#pragma unroll
        for (int mm = 0; mm < 8; ++mm) { if constexpr (!DIAG) sreg[mm] = snext[mm]; }
        LDS_BARRIER();
    };
    const int nit = (first < end) ? (end - first + stride - 1) / stride : 0;
    if (nit == 1) sample_body(first, std::true_type{}, std::true_type{});
    else if (nit >= 2) {
        sample_body(first, std::true_type{}, std::false_type{});
#pragma unroll 1
        for (int q = 1; q + 1 < nit; ++q) sample_body(first + q * stride, std::false_type{}, std::false_type{});
        sample_body(first + (nit - 1) * stride, std::false_type{}, std::true_type{});
    }
}
#undef SAMPLE_PREFETCH
#ifndef G3_SECOND_MODE
#define G3_SECOND_MODE 0
#endif
DEVI void phase_g3(const Params& p, unsigned char* lds, int bid, int nb, int rep) {
    const int mode = rep ? G3_SECOND_MODE : 0;
    if (bid < NCHAIN) { if (mode == 0 || mode == 1) { for (int c = bid; c < 128; c += NCHAIN) g3_chain<false>(p, lds, c); LDS_BARRIER(); g3_sample<false>(p, lds, NS_A + bid, NCHAIN, 4096); }
#if G3_SECOND_MODE == 3
        else if (mode == 3) { for (int c = bid; c < 128; c += NCHAIN) g3_chain<true>(p, lds, c); }
#endif
    } else { if (mode == 0 || mode == 2) g3_sample<false>(p, lds, bid - NCHAIN, nb - NCHAIN, NS_A);
#if G3_SECOND_MODE == 4
        else if (mode == 4) g3_sample<true>(p, lds, bid - NCHAIN, nb - NCHAIN, NS_A);
#endif
    }
}

constexpr int NPHASES = 17;
template <int PH> DEVI void run_phase(const Params& p, unsigned char* lds, int bid, int nb, int rep = 0) {
    unsigned char* ws = p.ws;
    bf16_t* H = (bf16_t*)(ws + WS_H); bf16_t* ACT = (bf16_t*)(ws + WS_ACT); float* X = (float*)(ws + WS_X);
    if constexpr (PH == 0) phase0(p, lds, bid, nb);
    else if constexpr (PH == 1) { EpiBf16<0> E; E.O = ACT; E.ldc = 6144; run_gemm(lds, H, (const bf16_t*)(ws + WS_WT_INA), 6144, 2048, E, bid, nb);
        if (nb == 256 && bid >= 96 && rep == 0) { LDS_BARRIER(); convert_tiles(p, lds, CV_P0_END + (bid - 96), 160, CV_G1_END); } }
    else if constexpr (PH == 2) phase_conv_a(p, bid, nb);
    else if constexpr (PH == 3) run_gemm_sk(lds, (const bf16_t*)(ws + WS_GB), (const bf16_t*)(ws + WS_WT_OUTA), 2048, (bf16_t*)(ws + WS_PA), (bf16_t*)(ws + WS_PB), bid, nb);
    else if constexpr (PH == 4) phase_rms(p, p.in[16], bid, nb, true);
    else if constexpr (PH == 5) { EpiBf16<1> E; E.O = ACT; E.ldc = 8192; run_gemm(lds, H, (const bf16_t*)(ws + WS_WT_UP0), 8192, 2048, E, bid, nb);
        if (nb == 256 && bid >= 128 && rep == 0) { LDS_BARRIER(); convert_tiles(p, lds, CV_G1_END + (bid - 128), 128, CV_NST); } }
    else if constexpr (PH == 6) run_gemm_sk(lds, ACT, (const bf16_t*)(ws + WS_WT_DN0), 8192, (bf16_t*)(ws + WS_PA), (bf16_t*)(ws + WS_PB), bid, nb);
    else if constexpr (PH == 7) phase_rms(p, p.in[9], bid, nb, false);
    else if constexpr (PH == 8) { EpiProj E; E.QKV = (bf16_t*)(ws + WS_QKV); E.Z = (bf16_t*)(ws + WS_Z); E.BA = (float*)(ws + WS_BA); run_gemm(lds, H, (const bf16_t*)(ws + WS_WT_INB), NPROJ_PAD, 2048, E, bid, nb); }
    else if constexpr (PH == 9) phase_g1(p, bid, nb);
    else if constexpr (PH == 10) phase_g2(p, lds, bid, nb);
    else if constexpr (PH == 11) phase_g3(p, lds, bid, nb, rep);
    else if constexpr (PH == 12) run_gemm_sk(lds, (const bf16_t*)(ws + WS_OG), (const bf16_t*)(ws + WS_WT_OUTB), 4096, (bf16_t*)(ws + WS_PA), (bf16_t*)(ws + WS_PB), bid, nb);
    else if constexpr (PH == 13) phase_rms(p, p.in[16] + D, bid, nb, false);
    else if constexpr (PH == 14) { EpiBf16<1> E; E.O = ACT; E.ldc = 8192; run_gemm(lds, H, (const bf16_t*)(ws + WS_WT_UP1), 8192, 2048, E, bid, nb); }
    else if constexpr (PH == 15) run_gemm_sk(lds, ACT, (const bf16_t*)(ws + WS_WT_DN1), 8192, (bf16_t*)(ws + WS_PA), (bf16_t*)(ws + WS_PB), bid, nb);
    else if constexpr (PH == 16) phase_rms_final(p, bid, nb);
}

#if MEGA
#ifndef REPS_INIT
#define REPS_INIT {1,1,1,1,1,1,1,1,1,1,1,1,1,1,1,1,1}
#endif
__device__ constexpr int kReps[NPHASES] = REPS_INIT;
template <int PH> DEVI void mega_phases(const Params& p, unsigned char* shm, cg::grid_group& grid, const XcdBarrier& xb, int bid, int nb) {
#pragma unroll 1
    for (int r = 0; r < kReps[PH]; ++r) { run_phase<PH>(p, shm, bid, nb, r);
        if (PH + 1 < NPHASES || r + 1 < kReps[PH]) xcd_barrier(xb); }
    if constexpr (PH + 1 < NPHASES) mega_phases<PH + 1>(p, shm, grid, xb, bid, nb);
}
__global__ void __launch_bounds__(512, 2) k_mega(Params p) {
    extern __shared__ __attribute__((aligned(16))) unsigned char shm[];
    cg::grid_group grid = cg::this_grid();
    if (gridDim.x == 0x7fffffffu) grid.sync();
    if (threadIdx.x < 4) ((LAS unsigned*)(shm + LDS_XB))[threadIdx.x] = 0u;
    __syncthreads();
    const XcdBarrier xb = xcd_barrier_post((unsigned*)(p.ws + WS_BAR), (volatile LAS unsigned*)(shm + LDS_XB));
    mega_phases<0>(p, shm, grid, xb, (int)blockIdx.x, (int)gridDim.x);
}
#else
template <int PH> __global__ void __launch_bounds__(512, 2) k_phase(Params p) {
    extern __shared__ __attribute__((aligned(16))) unsigned char shm[];
    run_phase<PH>(p, shm, blockIdx.x, gridDim.x);
}
template <int PH> static void launch_phase(const Params& p, int grid, hipStream_t stream) {
    static bool attr = false;
    if (!attr) { (void)hipFuncSetAttribute((const void*)k_phase<PH>, hipFuncAttributeMaxDynamicSharedMemorySize, LDS_BYTES); attr = true; }
    hipLaunchKernelGGL(k_phase<PH>, dim3(grid), dim3(512), LDS_BYTES, stream, p);
}
template <int PH> static void launch_all(const Params& p, int grid, hipStream_t stream) {
    launch_phase<PH>(p, grid, stream);
    if constexpr (PH + 1 < NPHASES) launch_all<PH + 1>(p, grid, stream);
}
#endif

extern "C" void kernel_launch(void* const* d_in, const int* in_sizes, int n_in, void* d_out, int out_size, void* d_ws, size_t ws_size, hipStream_t stream) {
    static int grid = 0;
    if (grid == 0) {
        if (n_in != 20 || ws_size < WS_END) { fprintf(stderr, "kernel_launch: need 20 inputs and %zu bytes of workspace (got %d, %zu)\n", (size_t)WS_END, n_in, ws_size); grid = -1; return; }
        int dev = 0, cus = 0, per_cu = 0;
        (void)hipGetDevice(&dev); (void)hipDeviceGetAttribute(&cus, hipDeviceAttributeMultiprocessorCount, dev);
#if MEGA
        if (hipFuncSetAttribute((const void*)k_mega, hipFuncAttributeMaxDynamicSharedMemorySize, LDS_BYTES) != hipSuccess) { fprintf(stderr, "kernel_launch: hipFuncSetAttribute failed\n"); grid = -1; return; }
        if (hipOccupancyMaxActiveBlocksPerMultiprocessor(&per_cu, (const void*)k_mega, 512, LDS_BYTES) != hipSuccess || per_cu < 1) { fprintf(stderr, "kernel_launch: occupancy query says %d blocks per CU\n", per_cu); grid = -1; return; }
#endif
        grid = cus;
        if (grid < NCHAIN + 1) { fprintf(stderr, "kernel_launch: %d CUs is too few\n", grid); grid = -1; return; }
    }
    if (grid < 0) return;
    Params p{};
    for (int i = 0; i < 20; ++i) p.in[i] = (const float*)d_in[i];
    p.out = (float*)d_out; p.ws = (unsigned char*)d_ws;
#if MEGA
    if (hipMemsetAsync((unsigned char*)d_ws + WS_BAR, 0, 16384, stream) != hipSuccess) { fprintf(stderr, "kernel_launch: hipMemsetAsync of the barrier words failed\n"); return; }
    void* args[] = {&p};
    hipError_t e = hipLaunchCooperativeKernel((const void*)k_mega, dim3(grid), dim3(512), args, LDS_BYTES, stream);
    if (e != hipSuccess) fprintf(stderr, "kernel_launch: cooperative launch failed: %s (grid %d)\n", hipGetErrorString(e), grid);
#else
    launch_all<0>(p, grid, stream);
#endif
}
```

```cpp
#include <hip/hip_runtime.h>
#include <hip/hip_cooperative_groups.h>
#include <cstdio>
#include <cstdint>
#include <type_traits>
namespace cg = cooperative_groups;
namespace pg8 {
#define PG8_LAS __attribute__((address_space(3)))
typedef unsigned short bf16_t;
typedef short bf16x8 __attribute__((ext_vector_type(8)));
typedef float f32x4 __attribute__((ext_vector_type(4)));
typedef unsigned u32x4 __attribute__((ext_vector_type(4)));
constexpr int BM = 256, BK = 64, HALF = 128, HTB = HALF * BK * 2  , STAGE_BYTES = 8 * HTB, NXCD = 8, WGM = 8;

__host__ __device__ __forceinline__ int lds_byte(int r, int c) { const int st = (r >> 4) * 2 + (c >> 5), rr = r & 15, cc = c & 31, ob = rr * 64 + cc * 2; return st * 1024 + (ob ^ (((ob >> 9) & 1) << 5)); }
__host__ __device__ __forceinline__ void stage_rc(int b, int& R, int& C) { const int st = b / 1024, sb = b % 1024, swz = sb ^ (((sb >> 9) & 1) << 5); R = (st >> 1) * 16 + swz / 64; C = (st & 1) * 32 + (swz % 64) / 2; }
__host__ __device__ __forceinline__ int perm32(int rho) { const int n = rho >> 4, i = rho & 15; return 8 * (i >> 2) + 4 * n + (i & 3); }

struct Unit { int pm, pn, kt0, nt; };
struct Gemm { const bf16_t* A; const bf16_t* Bt; int M, N, K; };

struct StaticOrder {
    int nM, nN, nwg, G, c, ntk;
    __host__ __device__ void init(int M, int N, int G_, int c_, int K_) { nM = M / BM; nN = N / BM; nwg = nM * nN; G = G_; c = c_; ntk = K_ / BK; }
    __host__ __device__ bool next(int i, Unit& u) const {
        const long L = (long)i * G + c; if (L >= nwg) return false;
        int wgid = (int)L; { const int q = nwg / NXCD, r = nwg % NXCD, xcd = wgid % NXCD, off = wgid / NXCD; wgid = (xcd < r ? xcd * (q + 1) : r * (q + 1) + (xcd - r) * q) + off; }
        const int nig = WGM * nN, gid = wgid / nig, fm = gid * WGM, gsz = (nM - fm) < WGM ? (nM - fm) : WGM;
        u.pm = fm + ((wgid % nig) % gsz); u.pn = (wgid % nig) / gsz; u.kt0 = 0; u.nt = ntk; return true;
    }
    __device__ __forceinline__ void a_ready(const Unit&) const {}
    __device__ __forceinline__ void done(const Unit&) const {}
};
typedef __bf16 bf16v2_t __attribute__((ext_vector_type(2)));
typedef float f32v2_t __attribute__((ext_vector_type(2)));
__device__ __forceinline__ unsigned cvt_pk_bf16(float lo, float hi) { const f32v2_t v = {lo, hi}; const bf16v2_t b = __builtin_convertvector(v, bf16v2_t); return __builtin_bit_cast(unsigned, b); }

template <class Epi, class Sched, bool STAMP = false>
__device__ __forceinline__ void gemm_phase(PG8_LAS unsigned char* lds, const Gemm g, const Sched& S, const Epi& E, unsigned long long* stamps) {
    int tid_ = (int)threadIdx.x; asm volatile("" : "+v"(tid_)); const int tid = tid_, wid = __builtin_amdgcn_readfirstlane(tid >> 6), lane = tid & 63, wr = wid >> 2, wc = wid & 3, fr = lane & 15, fq = lane >> 4;
    const int K = g.K;
    int ts_lo = 0, ts_hi = 0, nts = 0; const unsigned long long rt_entry = STAMP ? (unsigned long long)wall_clock64() : 0ull;
#define PG8_STAMP() do { if (STAMP && wid == 0 && nts < 64) { const unsigned long long _c = (unsigned long long)clock64(); \
        ts_lo = (lane == nts) ? (int)(unsigned)_c : ts_lo; ts_hi = (lane == nts) ? (int)(unsigned)(_c >> 32) : ts_hi; ++nts; } } while (0)
    PG8_STAMP();
    unsigned voffA[2], voffB[2];
#pragma unroll
    for (int i = 0; i < 2; ++i) { int R, C; stage_rc(tid * 16 + i * 8192, R, C); const int Rb = Epi::PERM ? ((R & ~31) + perm32(R & 31)) : R;
        voffA[i] = (unsigned)(R * K + C) * 2u; voffB[i] = (unsigned)(Rb * K + C) * 2u; }
    const size_t kstep = (size_t)(BK * 2);
    const size_t hstep = (size_t)HALF * K * 2;
    const size_t tstep = 2 * hstep;
    const unsigned ldsw = (unsigned)wid * 1024u;
    const int aoff = lds_byte(wr * 64 + fr, fq * 8), boff = lds_byte(wc * 32 + fr, fq * 8);
#define PG8_SA(b, h) (((b) * 2 + (h)) * HTB)
#define PG8_SB(b, h) ((4 + (b) * 2 + (h)) * HTB)
#define PG8_STAGE(bufoff, gbase, voff) do { _Pragma("unroll") for (int _i = 0; _i < 2; ++_i) \
        __builtin_amdgcn_global_load_lds((const unsigned*)((const char*)(gbase) + (voff)[_i]), (PG8_LAS unsigned*)(lds + (bufoff) + ldsw + _i * 8192), 16, 0, 0); } while (0)
#define PG8_LDA(dst, b, h) do { _Pragma("unroll") for (int m = 0; m < 4; ++m) _Pragma("unroll") for (int k = 0; k < 2; ++k) dst[m][k] = *(const PG8_LAS bf16x8*)(lds + PG8_SA(b, h) + aoff + m * 2048 + k * 1024); } while (0)
#define PG8_LDB(dst, b, h) do { _Pragma("unroll") for (int n = 0; n < 2; ++n) _Pragma("unroll") for (int k = 0; k < 2; ++k) dst[n][k] = *(const PG8_LAS bf16x8*)(lds + PG8_SB(b, h) + boff + n * 2048 + k * 1024); } while (0)
#define PG8_MMA(ai, bj, At, Bt) do { __builtin_amdgcn_s_setprio(1); _Pragma("unroll") for (int m = 0; m < 4; ++m) _Pragma("unroll") for (int n = 0; n < 2; ++n) _Pragma("unroll") for (int k = 0; k < 2; ++k) \
        acc[ai][bj][m][n] = __builtin_amdgcn_mfma_f32_16x16x32_bf16(Bt[n][k], At[m][k], acc[ai][bj][m][n], 0, 0, 0); __builtin_amdgcn_s_setprio(0); } while (0)
#define PG8_WAIT_V(n) asm volatile("s_waitcnt vmcnt(" #n ")" ::: "memory")
#define PG8_WAIT_L(n) asm volatile("s_waitcnt lgkmcnt(" #n ")" ::: "memory")
#define PG8_BAR __builtin_amdgcn_s_barrier()
#define PG8_SCHED __builtin_amdgcn_sched_barrier(0)
    Unit cur, nxt; int ui = 0;
    if (!S.next(0, cur)) return;
    f32x4 acc[2][2][4][2];
#pragma unroll
    for (int a = 0; a < 2; ++a)
#pragma unroll
        for (int b = 0; b < 2; ++b)
#pragma unroll
            for (int m = 0; m < 4; ++m)
#pragma unroll
                for (int n = 0; n < 2; ++n) acc[a][b][m][n] = (f32x4){0.f, 0.f, 0.f, 0.f};
    bf16x8 At[4][2], B0[2][2], B1[2][2];
    const char* cA = (const char*)g.A + (size_t)cur.pm * tstep + (size_t)cur.kt0 * kstep; const char* cB = (const char*)g.Bt + (size_t)cur.pn * tstep + (size_t)cur.kt0 * kstep;
    S.a_ready(cur);
    PG8_STAGE(PG8_SB(0, 0), cB, voffB); PG8_STAGE(PG8_SA(0, 0), cA, voffA); PG8_STAGE(PG8_SB(0, 1), cB + hstep, voffB); PG8_STAGE(PG8_SA(0, 1), cA + hstep, voffA);
    if (wr == 1) PG8_BAR;
    PG8_WAIT_V(4); PG8_BAR;
    PG8_STAGE(PG8_SB(1, 0), cB + kstep, voffB); PG8_STAGE(PG8_SA(1, 0), cA + kstep, voffA); PG8_STAGE(PG8_SB(1, 1), cB + hstep + kstep, voffB);
    PG8_WAIT_V(6); PG8_BAR;
    PG8_STAMP();
    for (;;) {
        const bool has_next = S.next(ui + 1, nxt);
        const char* nA = has_next ? (const char*)g.A + (size_t)nxt.pm * tstep + (size_t)nxt.kt0 * kstep : cA; const char* nB = has_next ? (const char*)g.Bt + (size_t)nxt.pn * tstep + (size_t)nxt.kt0 * kstep : cB;
        const int nt = cur.nt;
        for (int t = 0; t < nt; t += 2) {
            const bool last = (t == nt - 2);
            const char* a1 = cA + (size_t)(t + 1) * kstep;
            const char* a2 = last ? nA : cA + (size_t)(t + 2) * kstep; const char* b2 = last ? nB : cB + (size_t)(t + 2) * kstep;
            const char* a3 = a2 + kstep; const char* b3 = b2 + kstep;
            if (last && has_next) S.a_ready(nxt);
            PG8_LDB(B0, 0, 0); PG8_SCHED; PG8_LDA(At, 0, 0); PG8_STAGE(PG8_SA(1, 1), a1 + hstep, voffA);
            PG8_WAIT_L(8); PG8_BAR; PG8_WAIT_L(0); PG8_MMA(0, 0, At, B0); PG8_BAR; PG8_SCHED;
            PG8_LDB(B1, 0, 1); PG8_STAGE(PG8_SB(0, 0), b2, voffB);
            PG8_BAR; PG8_WAIT_L(0); PG8_MMA(0, 1, At, B1); PG8_BAR;
            PG8_LDA(At, 0, 1); PG8_STAGE(PG8_SA(0, 0), a2, voffA);
            PG8_BAR; PG8_WAIT_L(0); PG8_MMA(1, 0, At, B0); PG8_BAR; PG8_SCHED;
            PG8_STAGE(PG8_SB(0, 1), b2 + hstep, voffB);
            PG8_WAIT_V(6); PG8_BAR; PG8_MMA(1, 1, At, B1); PG8_BAR;
            PG8_LDB(B0, 1, 0); PG8_SCHED; PG8_LDA(At, 1, 0); PG8_STAGE(PG8_SA(0, 1), a2 + hstep, voffA);
            PG8_WAIT_L(8); PG8_BAR; PG8_WAIT_L(0); PG8_MMA(0, 0, At, B0); PG8_BAR; PG8_SCHED;
            PG8_LDB(B1, 1, 1); PG8_STAGE(PG8_SB(1, 0), b3, voffB);
            PG8_BAR; PG8_WAIT_L(0); PG8_MMA(0, 1, At, B1); PG8_BAR;
            PG8_LDA(At, 1, 1); PG8_STAGE(PG8_SA(1, 0), a3, voffA);
            PG8_BAR; PG8_WAIT_L(0); PG8_MMA(1, 0, At, B0); PG8_BAR; PG8_SCHED;
            PG8_STAGE(PG8_SB(1, 1), b3 + hstep, voffB);
            PG8_WAIT_V(6); PG8_BAR; PG8_MMA(1, 1, At, B1); PG8_BAR;
        }
        PG8_STAMP();
        if constexpr (!Epi::AFTER_DRAIN) { E(acc, cur, wr, wc, fr, fq); S.done(cur); }
        PG8_STAMP();
        if (!has_next) break;
#pragma unroll
        for (int a = 0; a < 2; ++a)
#pragma unroll
            for (int b = 0; b < 2; ++b)
#pragma unroll
                for (int m = 0; m < 4; ++m)
#pragma unroll
                    for (int n = 0; n < 2; ++n) acc[a][b][m][n] = (f32x4){0.f, 0.f, 0.f, 0.f};
        cur = nxt; cA = nA; cB = nB; ++ui;
    }
    PG8_WAIT_V(0);
    if (wr == 0) PG8_BAR;
    PG8_BAR;
    if constexpr (Epi::AFTER_DRAIN) { E.fused(acc, cur, wr, wc, fr, fq, lds, wid, lane); S.done(cur); }
    PG8_STAMP();
    if (STAMP && wid == 0) { stamps[lane] = lane < nts ? (((unsigned long long)(unsigned)ts_hi << 32) | (unsigned)ts_lo) : 0ull;
        if (lane == 62) stamps[62] = rt_entry; if (lane == 63) stamps[63] = (unsigned long long)wall_clock64(); }
#undef PG8_STAMP
#undef PG8_SA
#undef PG8_SB
#undef PG8_STAGE
#undef PG8_LDA
#undef PG8_LDB
#undef PG8_MMA
#undef PG8_WAIT_V
#undef PG8_WAIT_L
#undef PG8_BAR
#undef PG8_SCHED
}
}

#define XB_TMO      128
#define XB_XCNT(j)  (256  + 64 * (j))
#define XB_XSUB(j)  (1280 + 64 * (j))
#define XB_XGEN(j)  (2304 + 64 * (j))
#define XB_TOP      3328
#define XB_TOPGEN   3392
#define XCD_BAR_WORDS 3456
#define XB_SPIN_CAP (1u << 18)
#define LAS __attribute__((address_space(3)))

__device__ __forceinline__ unsigned xb_ld(unsigned* p)              { return __hip_atomic_load(p, __ATOMIC_RELAXED, __HIP_MEMORY_SCOPE_AGENT); }
__device__ __forceinline__ unsigned xb_add(unsigned* p, unsigned v) { return __hip_atomic_fetch_add(p, v, __ATOMIC_RELAXED, __HIP_MEMORY_SCOPE_AGENT); }
__device__ __forceinline__ unsigned xb_xcc_id() { return (unsigned)__builtin_amdgcn_s_getreg((3 << 11) | 20) & 0xFu; }
#define XB_SPIN(cond, bar) do { unsigned _sp = 0; while (cond) { __builtin_amdgcn_s_sleep(1); \
    if ((++_sp & 255u) == 0u) { if (xb_ld(&(bar)[XB_TMO])) break; if (_sp > XB_SPIN_CAP) { atomicAdd(&(bar)[XB_TMO], 1u); break; } } } } while (0)

struct XcdBarrier {
    unsigned* bar; unsigned x;
    volatile LAS unsigned* st;
};

__device__ __forceinline__ XcdBarrier xcd_barrier_post(unsigned* bar, volatile LAS unsigned* st) {
    XcdBarrier b; b.bar = bar; b.x = xb_xcc_id(); b.st = st;
    if (threadIdx.x == 0) (void)xb_add(&bar[XB_XCNT(b.x)], 1u);
    return b;
}
__device__ __forceinline__ void xcd_barrier_complete(unsigned* bar, unsigned x, unsigned& nloc, unsigned& nx) {
    const unsigned G = gridDim.x * gridDim.y * gridDim.z;
    unsigned sum, cnt, mine, sp = 0u;
    for (;;) {
        sum = 0u; cnt = 0u; mine = 0u;
#pragma unroll
        for (unsigned j = 0; j < 16; ++j) { const unsigned c = xb_ld(&bar[XB_XCNT(j)]); sum += c; cnt += (c > 0u) ? 1u : 0u; mine = (j == x) ? c : mine; }
        if (sum == G) break;
        __builtin_amdgcn_s_sleep(1);
        if ((++sp & 255u) == 0u) { if (xb_ld(&bar[XB_TMO])) break; if (sp > XB_SPIN_CAP) { atomicAdd(&bar[XB_TMO], 1u); break; } }
    }
    nloc = mine > 0u ? mine : 1u; nx = cnt > 0u ? cnt : 1u;
}

__device__ __forceinline__ void xcd_barrier(const XcdBarrier& b) {
    asm volatile("s_waitcnt vmcnt(0)" ::: "memory");
    __syncthreads();
    if (threadIdx.x == 0) {
        unsigned* bar = b.bar;
        __builtin_amdgcn_s_waitcnt(0);
        unsigned nloc = b.st[0], nx = b.st[1];
        if (nloc == 0u) { xcd_barrier_complete(bar, b.x, nloc, nx); b.st[0] = nloc; b.st[1] = nx; }
        const unsigned old = xb_add(&bar[XB_XSUB(b.x)], 1u);
        const unsigned gen = old / nloc;
        if (old + 1u == (gen + 1u) * nloc) {
            __builtin_amdgcn_fence(__ATOMIC_RELEASE, "agent");
            asm volatile("s_waitcnt vmcnt(0)" ::: "memory");
            const unsigned og = xb_add(&bar[XB_TOP], 1u);
            const unsigned tg = og / nx;
            if (og + 1u == (tg + 1u) * nx) xb_add(&bar[XB_TOPGEN], 1u);
            else XB_SPIN(xb_ld(&bar[XB_TOPGEN]) == tg, bar);
            __builtin_amdgcn_fence(__ATOMIC_ACQUIRE, "agent");
            xb_add(&bar[XB_XGEN(b.x)], 1u);
            asm volatile("s_waitcnt vmcnt(0)" ::: "memory");
        } else {
            XB_SPIN(xb_ld(&bar[XB_XGEN(b.x)]) == gen, bar);
            __builtin_amdgcn_fence(__ATOMIC_ACQUIRE, "agent");
            asm volatile("s_waitcnt vmcnt(0)" ::: "memory");
        }
    }
    __syncthreads();
}

using pg8::bf16_t; using pg8::bf16x8; using pg8::f32x4; using pg8::u32x4;
#define DEVI __device__ __forceinline__
DEVI int otid() { int t = (int)hipThreadIdx_x; asm volatile("" : "+v"(t)); return t; }
#ifndef MEGA
#define MEGA 1
#endif

constexpr int D = 2048, TP = 8192, TS = 1024, T = 9216, DFF = 8192;
constexpr int NPROJ = 12352, NPROJ_PAD = 12544;
constexpr float EPS = 1e-6f;
constexpr int LDS_XB = 73728 + 65536;
constexpr int LDS_BYTES = LDS_XB + 16;
constexpr int NCHAIN = 128;
constexpr int NS_A = 32 * 128;

constexpr size_t WS_WT_INA = 0;
constexpr size_t WS_WT_OUTA = WS_WT_INA + (size_t)6144 * 2048 * 2;
constexpr size_t WS_WT_UP0 = WS_WT_OUTA + (size_t)2048 * 2048 * 2;
constexpr size_t WS_WT_DN0 = WS_WT_UP0 + (size_t)8192 * 2048 * 2;
constexpr size_t WS_WT_INB = WS_WT_DN0 + (size_t)8192 * 2048 * 2;
constexpr size_t WS_WT_OUTB = WS_WT_INB + (size_t)NPROJ_PAD * 2048 * 2;
constexpr size_t WS_WT_UP1 = WS_WT_OUTB + (size_t)2048 * 4096 * 2;
constexpr size_t WS_WT_DN1 = WS_WT_UP1 + (size_t)8192 * 2048 * 2;
constexpr size_t WS_X = WS_WT_DN1 + (size_t)8192 * 2048 * 2;
constexpr size_t WS_H = WS_X + (size_t)T * D * 4;
constexpr size_t WS_GB = WS_H + (size_t)T * D * 2;
constexpr size_t WS_OG = WS_H;
constexpr size_t WS_ACT = WS_GB + (size_t)T * D * 2;
constexpr size_t WS_QKV = WS_ACT;
constexpr size_t WS_Z = WS_ACT + (size_t)T * 8192 * 2;
constexpr size_t WS_BA = WS_ACT + (size_t)T * 12288 * 2;
constexpr size_t WS_QN = WS_BA + (size_t)T * 64 * 4;
constexpr size_t WS_KN = WS_QN + (size_t)T * D * 2;
constexpr size_t WS_VS = WS_KN + (size_t)T * D * 2;
constexpr size_t WS_KT = WS_VS + (size_t)TS * 4096 * 2;
constexpr size_t WS_VT = WS_KT + (size_t)TP * 2048 * 2;
constexpr size_t WS_BETA = WS_VT + (size_t)TP * 4096 * 2;
constexpr size_t WS_GG = WS_BETA + (size_t)T * 32 * 4;
constexpr size_t WS_GC = WS_GG + (size_t)T * 32 * 4;
constexpr size_t WS_UT = WS_GC + (size_t)TP * 32 * 4;
constexpr size_t WS_WW = WS_UT + (size_t)TP * 4096 * 2;
constexpr size_t WS_QKM = WS_WW + (size_t)TP * 4096 * 2;
constexpr size_t WS_PB = WS_QKM + (size_t)4096 * 4096 * 2;
constexpr size_t WS_PA = WS_PB + (size_t)T * D * 2;
constexpr size_t WS_BAR = WS_PB + (size_t)T * D * 4;
constexpr size_t WS_END = WS_BAR + 16384;

constexpr size_t O_YP = 0;
constexpr size_t O_YS = O_YP + (size_t)TP * D;
constexpr size_t O_CAP = O_YS + (size_t)TS * D;
constexpr size_t O_CBP = O_CAP + (size_t)4 * 2 * 2048;
constexpr size_t O_SSP = O_CBP + (size_t)4 * 3 * 8192;
constexpr size_t O_CAS = O_SSP + (size_t)4 * 32 * 16384;
constexpr size_t O_CBS = O_CAS + (size_t)128 * 2 * 2048;
constexpr size_t O_SSS = O_CBS + (size_t)128 * 3 * 8192;

struct Params { const float* in[20]; float* out; unsigned char* ws; };

DEVI float bf2f(unsigned short b) { return __uint_as_float(((unsigned)b) << 16); }
DEVI unsigned pk2(float lo, float hi) { return pg8::cvt_pk_bf16(lo, hi); }
DEVI unsigned short f2bf(float f) { return (unsigned short)(pk2(f, 0.f) & 0xffffu); }
DEVI float silu_f(float a) { return a * __builtin_amdgcn_rcpf(1.f + __expf(-a)); }
DEVI float wave_sum(float v) {
#pragma unroll
    for (int o = 1; o < 64; o <<= 1) v += __shfl_xor(v, o);
    return v;
}
DEVI void unpack8(u32x4 w, float (&f)[8]) {
    f[0] = __uint_as_float(w.x << 16); f[1] = __uint_as_float(w.x & 0xffff0000u);
    f[2] = __uint_as_float(w.y << 16); f[3] = __uint_as_float(w.y & 0xffff0000u);
    f[4] = __uint_as_float(w.z << 16); f[5] = __uint_as_float(w.z & 0xffff0000u);
    f[6] = __uint_as_float(w.w << 16); f[7] = __uint_as_float(w.w & 0xffff0000u);
}
DEVI u32x4 pack8(const float (&f)[8]) { u32x4 w; w.x = pk2(f[0], f[1]); w.y = pk2(f[2], f[3]); w.z = pk2(f[4], f[5]); w.w = pk2(f[6], f[7]); return w; }
DEVI void ld8f(const float* p, float (&f)[8]) { f32x4 a = *(const f32x4*)p, b = *(const f32x4*)(p + 4); f[0] = a.x; f[1] = a.y; f[2] = a.z; f[3] = a.w; f[4] = b.x; f[5] = b.y; f[6] = b.z; f[7] = b.w; }
DEVI void st8f(float* p, const float (&f)[8]) { *(f32x4*)p = (f32x4){f[0], f[1], f[2], f[3]}; *(f32x4*)(p + 4) = (f32x4){f[4], f[5], f[6], f[7]}; }
DEVI f32x4 mfma16(bf16x8 a, bf16x8 b, f32x4 c) { return __builtin_amdgcn_mfma_f32_16x16x32_bf16(a, b, c, 0, 0, 0); }
DEVI bf16x8 ldfrag(const bf16_t* p) { return *(const bf16x8*)p; }
#define LDS_BARRIER() do { asm volatile("s_waitcnt lgkmcnt(0)" ::: "memory"); __builtin_amdgcn_s_barrier(); asm volatile("" ::: "memory"); } while (0)
#define WAVE_LDS_SYNC() do { asm volatile("s_waitcnt lgkmcnt(0)" ::: "memory"); __builtin_amdgcn_wave_barrier(); } while (0)

template <int ACT> struct EpiBf16 {
    static constexpr bool PERM = true, AFTER_DRAIN = false;
    bf16_t* O; int ldc;
    DEVI void operator()(const f32x4 (&acc)[2][2][4][2], const pg8::Unit& u, int wr, int wc, int fr, int fq) const {
        const int row0 = u.pm * 256 + wr * 64 + fr, col0 = u.pn * 256 + wc * 32 + 8 * fq;
#pragma unroll
        for (int ai = 0; ai < 2; ++ai)
#pragma unroll
            for (int m = 0; m < 4; ++m) { bf16_t* rowp = O + (size_t)(row0 + ai * 128 + m * 16) * ldc + col0;
#pragma unroll
                for (int bj = 0; bj < 2; ++bj) { f32x4 v0 = acc[ai][bj][m][0], v1 = acc[ai][bj][m][1];
                    if (ACT == 1) {
#pragma unroll
                        for (int j = 0; j < 4; ++j) { float a = fmaxf(v0[j], 0.f), b = fmaxf(v1[j], 0.f); v0[j] = a * a; v1[j] = b * b; } }
                    u32x4 w; w.x = pk2(v0[0], v0[1]); w.y = pk2(v0[2], v0[3]); w.z = pk2(v1[0], v1[1]); w.w = pk2(v1[2], v1[3]);
                    *(u32x4*)(rowp + bj * 128) = w; } }
    }
};
struct EpiResid {
    static constexpr bool PERM = false, AFTER_DRAIN = false;
    float* X; const float* rp; const float* rs;
    DEVI void operator()(const f32x4 (&acc)[2][2][4][2], const pg8::Unit& u, int wr, int wc, int fr, int fq) const {
        const int row0 = u.pm * 256 + wr * 64 + fr, col0 = u.pn * 256 + wc * 32 + 4 * fq;
        const float* R = (u.pm * 256 < TP) ? rp : (rs - (size_t)TP * D);
#pragma unroll
        for (int ai = 0; ai < 2; ++ai)
#pragma unroll
            for (int m = 0; m < 4; ++m) { const size_t ro = (size_t)(row0 + ai * 128 + m * 16) * D + col0;
#pragma unroll
                for (int bj = 0; bj < 2; ++bj)
#pragma unroll
                    for (int n = 0; n < 2; ++n) { const f32x4 r = *(const f32x4*)(R + ro + bj * 128 + n * 16); *(f32x4*)(X + ro + bj * 128 + n * 16) = acc[ai][bj][m][n] + r; } }
    }
};
struct EpiProj {
    static constexpr bool PERM = true, AFTER_DRAIN = false;
    bf16_t* QKV; bf16_t* Z; float* BA;
    DEVI void operator()(const f32x4 (&acc)[2][2][4][2], const pg8::Unit& u, int wr, int wc, int fr, int fq) const {
        const int row0 = u.pm * 256 + wr * 64 + fr; const int colt = u.pn * 256;
        if (colt < 12288) {
            bf16_t* base; int ldc, c0;
            if (colt < 8192) { base = QKV; ldc = 8192; c0 = colt; } else { base = Z; ldc = 4096; c0 = colt - 8192; }
            const int col0 = c0 + wc * 32 + 8 * fq;
#pragma unroll
            for (int ai = 0; ai < 2; ++ai)
#pragma unroll
                for (int m = 0; m < 4; ++m) { bf16_t* rowp = base + (size_t)(row0 + ai * 128 + m * 16) * ldc + col0;
#pragma unroll
                    for (int bj = 0; bj < 2; ++bj) { const f32x4 v0 = acc[ai][bj][m][0], v1 = acc[ai][bj][m][1];
                        u32x4 w; w.x = pk2(v0[0], v0[1]); w.y = pk2(v0[2], v0[3]); w.z = pk2(v1[0], v1[1]); w.w = pk2(v1[2], v1[3]);
                        *(u32x4*)(rowp + bj * 128) = w; } }
        } else if (wc < 2) {
#pragma unroll
            for (int ai = 0; ai < 2; ++ai)
#pragma unroll
                for (int m = 0; m < 4; ++m) { float* rowp = BA + (size_t)(row0 + ai * 128 + m * 16) * 64 + wc * 32 + 8 * fq;
                    *(f32x4*)(rowp) = acc[ai][0][m][0]; *(f32x4*)(rowp + 4) = acc[ai][0][m][1]; }
        }
    }
};

struct StreamKOrder {
    int ntk, per, c;
    DEVI void init(int K, int G, int c_) { ntk = K / 64; per = (288 * ntk) / G; c = c_; }
    DEVI bool next(int i, pg8::Unit& u) const {
        const int s = c * per, e = s + per; int p0 = s;
        if (i >= 1) p0 = (s / ntk + 1) * ntk;
        if (i >= 2) p0 = (s / ntk + 2) * ntk;
        if (p0 >= e) return false;
        const int L = p0 / ntk, k = L / 9, r = L - 9 * k; int pend = (L + 1) * ntk; if (pend > e) pend = e;
        u.pn = k & 7; u.pm = r * 4 + (k >> 3); u.kt0 = p0 - L * ntk; u.nt = pend - p0; return true;
    }
    DEVI void a_ready(const pg8::Unit&) const {}
    DEVI void done(const pg8::Unit&) const {}
};
DEVI bool sk_has_pb(int pm, int pn) { const int k = (pm & 3) * 8 + pn, r = pm >> 2, L = r + 9 * k; return ((8 * L) % 9) >= 2; }
struct EpiSK {
    static constexpr bool PERM = true, AFTER_DRAIN = false;
    bf16_t* PA; bf16_t* PB;
    DEVI void operator()(const f32x4 (&acc)[2][2][4][2], const pg8::Unit& u, int wr, int wc, int fr, int fq) const {
        const int row0 = u.pm * 256 + wr * 64 + fr, col0 = u.pn * 256 + wc * 32 + 8 * fq;
        bf16_t* P = (u.kt0 == 0) ? PA : PB;
#pragma unroll
        for (int ai = 0; ai < 2; ++ai)
#pragma unroll
            for (int m = 0; m < 4; ++m) { bf16_t* rowp = P + (size_t)(row0 + ai * 128 + m * 16) * D + col0;
#pragma unroll
                for (int bj = 0; bj < 2; ++bj) { const f32x4 v0 = acc[ai][bj][m][0], v1 = acc[ai][bj][m][1];
                    u32x4 w; w.x = pk2(v0[0], v0[1]); w.y = pk2(v0[2], v0[3]); w.z = pk2(v1[0], v1[1]); w.w = pk2(v1[2], v1[3]);
                    *(u32x4*)(rowp + bj * 128) = w; } }
    }
};
DEVI void run_gemm_sk(unsigned char* lds, const bf16_t* A, const bf16_t* Bt, int K, bf16_t* PA, bf16_t* PB, int bid, int nb) {
    pg8::Gemm g; g.A = A; g.Bt = Bt; g.M = T; g.N = 2048; g.K = K;
    StreamKOrder S; S.init(K, nb, bid);
    EpiSK E; E.PA = PA; E.PB = PB;
    pg8::gemm_phase<EpiSK, StreamKOrder, false>((PG8_LAS unsigned char*)lds, g, S, E, nullptr);
}
template <class Epi> DEVI void run_gemm(unsigned char* lds, const bf16_t* A, const bf16_t* Bt, int N, int K, const Epi& E, int bid, int nb) {
    pg8::Gemm g; g.A = A; g.Bt = Bt; g.M = T; g.N = N; g.K = K;
    pg8::StaticOrder S; S.init(T, N, nb, bid, K);
    pg8::gemm_phase<Epi, pg8::StaticOrder, false>((PG8_LAS unsigned char*)lds, g, S, E, nullptr);
}

DEVI void transpose_load(const float* W, int N, int k0, int n0, int lane, f32x4 (&v)[16]) {
    const float* src = W + (size_t)(k0 + (lane >> 4)) * N + n0 + (lane & 15) * 4;
#pragma unroll
    for (int i = 0; i < 16; ++i) v[i] = *(const f32x4*)(src + (size_t)(4 * i) * N);
}
DEVI void transpose_store(const f32x4 (&v)[16], int K, bf16_t* WT, float* scr, int k0, int n0, int lane) {
#pragma unroll
    for (int i = 0; i < 16; ++i) { float* d = scr + (4 * i + (lane >> 4)) * 65 + (lane & 15) * 4; d[0] = v[i].x; d[1] = v[i].y; d[2] = v[i].z; d[3] = v[i].w; }
    WAVE_LDS_SYNC();
    const int c = lane & 7;
#pragma unroll
    for (int j = 0; j < 8; ++j) { const int n = (lane >> 3) + 8 * j; const float* s = scr + (8 * c) * 65 + n;
        u32x4 o; o.x = pk2(s[0 * 65], s[1 * 65]); o.y = pk2(s[2 * 65], s[3 * 65]); o.z = pk2(s[4 * 65], s[5 * 65]); o.w = pk2(s[6 * 65], s[7 * 65]);
        *(u32x4*)(WT + (size_t)(n0 + n) * K + k0 + 8 * c) = o; }
    WAVE_LDS_SYNC();
}
DEVI f32x4 ldpb4(const bf16_t* pb, int idx4) { const unsigned long long r = ((const unsigned long long*)pb)[idx4]; return (f32x4){__uint_as_float((unsigned)r << 16), __uint_as_float((unsigned)r & 0xffff0000u), __uint_as_float((unsigned)(r >> 32) << 16), __uint_as_float((unsigned)(r >> 32) & 0xffff0000u)}; }
template <int MODE> DEVI void rms_row_bf16(const float* xr, const float* w, bf16_t* o, int lane, float* xcopy = nullptr, const bf16_t* pa = nullptr, const bf16_t* pb = nullptr, int pm = 0) {
    f32x4 v[8], q[8], qa[8]; float s = 0.f;
#pragma unroll
    for (int j = 0; j < 8; ++j) { v[j] = ((const f32x4*)xr)[lane + 64 * j];
        if (MODE == 2) { qa[j] = ldpb4(pa, lane + 64 * j); if (sk_has_pb(pm, j)) q[j] = ldpb4(pb, lane + 64 * j); else q[j] = (f32x4){0.f, 0.f, 0.f, 0.f}; } }
    f32x4 ww[8];
#pragma unroll
    for (int j = 0; j < 8; ++j) ww[j] = ((const f32x4*)w)[lane + 64 * j];
#pragma unroll
    for (int j = 0; j < 8; ++j) { if (MODE == 2) v[j] = v[j] + (qa[j] + q[j]); s += (v[j].x * v[j].x + v[j].y * v[j].y) + (v[j].z * v[j].z + v[j].w * v[j].w); }
    const float r = rsqrtf(wave_sum(s) * (1.f / D) + EPS);
#pragma unroll
    for (int j = 0; j < 8; ++j) { if (MODE == 2) ((f32x4*)xcopy)[lane + 64 * j] = v[j];
        const unsigned lo = pk2(v[j].x * r * ww[j].x, v[j].y * r * ww[j].y), hi = pk2(v[j].z * r * ww[j].z, v[j].w * r * ww[j].w);
        ((unsigned long long*)o)[lane + 64 * j] = (unsigned long long)lo | ((unsigned long long)hi << 32); }
}
DEVI void rms_row_f32(const float* xr, const float* w, float* o, int lane, const bf16_t* pa, const bf16_t* pb, int pm) {
    f32x4 v[8], q[8], ww[8]; float s = 0.f;
#pragma unroll
    for (int j = 0; j < 8; ++j) { v[j] = ((const f32x4*)xr)[lane + 64 * j]; if (sk_has_pb(pm, j)) q[j] = ldpb4(pb, lane + 64 * j); else q[j] = (f32x4){0.f, 0.f, 0.f, 0.f}; ww[j] = ((const f32x4*)w)[lane + 64 * j]; }
#pragma unroll
    for (int j = 0; j < 8; ++j) { v[j] = v[j] + (q[j] + ldpb4(pa, lane + 64 * j)); s += (v[j].x * v[j].x + v[j].y * v[j].y) + (v[j].z * v[j].z + v[j].w * v[j].w); }
    const float r = rsqrtf(wave_sum(s) * (1.f / D) + EPS);
#pragma unroll
    for (int j = 0; j < 8; ++j) ((f32x4*)o)[lane + 64 * j] = (f32x4){v[j].x * r * ww[j].x, v[j].y * r * ww[j].y, v[j].z * r * ww[j].z, v[j].w * r * ww[j].w};
}
constexpr int CV_S0 = 8 * 48, CV_S1 = 8 * 16, CV_S2 = 8 * 64, CV_S3 = 32 * 16, CV_S4 = 8 * 97, CV_S5 = 16 * 16;
constexpr int CV_NST = CV_S0 + CV_S1 + CV_S2 + CV_S3 + CV_S4 + CV_S5 + CV_S2 + CV_S3;
constexpr int CV_G1 = 160 * 5, CV_G3 = 128 * 5, CV_P0_END = CV_NST - CV_G1 - CV_G3, CV_G1_END = CV_P0_END + CV_G1;
DEVI void convert_tiles(const Params& p, unsigned char* lds, int first, int stride, int end) {
    const int lane = otid() & 63, wave = otid() >> 6;
    float* scr = (float*)(lds + wave * 16640);
    unsigned char* ws = p.ws;
    const int kq = wave & 3, nq = wave >> 2;
    auto decode = [&](int st, const float*& W, bf16_t*& WT, int& K, int& N, int& k0, int& n0) -> bool {
        if (st >= end) return false;
        int r = st;
        if (r < CV_S0) { W = p.in[6]; WT = (bf16_t*)(ws + WS_WT_INA); K = 2048; N = 6144; }
        else if ((r -= CV_S0) < CV_S1) { W = p.in[8]; WT = (bf16_t*)(ws + WS_WT_OUTA); K = 2048; N = 2048; }
        else if ((r -= CV_S1) < CV_S2) { W = p.in[17]; WT = (bf16_t*)(ws + WS_WT_UP0); K = 2048; N = 8192; }
        else if ((r -= CV_S2) < CV_S3) { W = p.in[18]; WT = (bf16_t*)(ws + WS_WT_DN0); K = 8192; N = 2048; }
        else if ((r -= CV_S3) < CV_S4) { W = p.in[10]; WT = (bf16_t*)(ws + WS_WT_INB); K = 2048; N = NPROJ; }
        else if ((r -= CV_S4) < CV_S5) { W = p.in[15]; WT = (bf16_t*)(ws + WS_WT_OUTB); K = 4096; N = 2048; }
        else if ((r -= CV_S5) < CV_S2) { W = p.in[17] + (size_t)2048 * 8192; WT = (bf16_t*)(ws + WS_WT_UP1); K = 2048; N = 8192; }
        else { r -= CV_S2; W = p.in[18] + (size_t)8192 * 2048; WT = (bf16_t*)(ws + WS_WT_DN1); K = 8192; N = 2048; }
        const int nsb = (N + 127) / 128, KB = r / nsb, NB = r - KB * nsb;
        k0 = 256 * KB + 64 * kq; n0 = 128 * NB + 64 * nq;
        return n0 < N;
    };
    for (int st = first; st < end; st += 2 * stride) {
        const float *Wa = nullptr, *Wb = nullptr; bf16_t *WTa = nullptr, *WTb = nullptr; int Ka = 0, Na = 0, ka = 0, na = 0, Kb = 0, Nb = 0, kb = 0, nb2 = 0;
        const bool va = decode(st, Wa, WTa, Ka, Na, ka, na), vb = decode(st + stride, Wb, WTb, Kb, Nb, kb, nb2);
        f32x4 ta[16], tb[16];
        if (va) transpose_load(Wa, Na, ka, na, lane, ta);
        if (vb) transpose_load(Wb, Nb, kb, nb2, lane, tb);
        if (va) transpose_store(ta, Ka, WTa, scr, ka, na, lane);
        if (vb) transpose_store(tb, Kb, WTb, scr, kb, nb2, lane);
    }
}
DEVI void phase0(const Params& p, unsigned char* lds, int bid, int nb) {
    const int lane = otid() & 63, wave = otid() >> 6;
    const int gw = bid * 8 + wave, NGW = nb * 8;
    unsigned char* ws = p.ws;
    convert_tiles(p, lds, bid, nb, nb == 256 ? CV_P0_END : CV_NST);
    bf16_t* H = (bf16_t*)(ws + WS_H);
    f32x4 ww[8];
#pragma unroll
    for (int j = 0; j < 8; ++j) ww[j] = ((const f32x4*)p.in[5])[lane + 64 * j];
    auto finish = [&](f32x4 (&v)[8], bf16_t* o) { float s = 0.f;
#pragma unroll
        for (int j = 0; j < 8; ++j) s += (v[j].x * v[j].x + v[j].y * v[j].y) + (v[j].z * v[j].z + v[j].w * v[j].w);
        const float r = rsqrtf(wave_sum(s) * (1.f / D) + EPS);
#pragma unroll
        for (int j = 0; j < 8; ++j) { const unsigned lo = pk2(v[j].x * r * ww[j].x, v[j].y * r * ww[j].y), hi = pk2(v[j].z * r * ww[j].z, v[j].w * r * ww[j].w);
            ((unsigned long long*)o)[lane + 64 * j] = (unsigned long long)lo | ((unsigned long long)hi << 32); } };
    for (int row = gw; row < T; row += 2 * NGW) {
        const int row2 = row + NGW; const bool has2 = row2 < T;
        const float* srcA = row < TP ? p.in[0] + (size_t)row * D : p.in[1] + (size_t)(row - TP) * D;
        const float* srcB = row2 < TP ? p.in[0] + (size_t)row2 * D : p.in[1] + (size_t)(row2 - TP) * D;
        f32x4 va[8], vb[8];
#pragma unroll
        for (int j = 0; j < 8; ++j) va[j] = ((const f32x4*)srcA)[lane + 64 * j];
        if (has2) {
#pragma unroll
            for (int j = 0; j < 8; ++j) vb[j] = ((const f32x4*)srcB)[lane + 64 * j]; }
        finish(va, H + (size_t)row * D);
        if (has2) finish(vb, H + (size_t)row2 * D);
    }
}
DEVI void rms2_load(const float* xr, const bf16_t* pa, const bf16_t* pb, int pm, int lane, f32x4 (&v)[8], unsigned long long (&ra)[8], unsigned long long (&rb)[8]) {
#pragma unroll
    for (int j = 0; j < 8; ++j) { v[j] = ((const f32x4*)xr)[lane + 64 * j]; ra[j] = ((const unsigned long long*)pa)[lane + 64 * j]; rb[j] = sk_has_pb(pm, j) ? ((const unsigned long long*)pb)[lane + 64 * j] : 0ull; }
}
DEVI f32x4 unpk4(unsigned long long r) { return (f32x4){__uint_as_float((unsigned)r << 16), __uint_as_float((unsigned)r & 0xffff0000u), __uint_as_float((unsigned)(r >> 32) << 16), __uint_as_float((unsigned)(r >> 32) & 0xffff0000u)}; }
DEVI void rms2_finish(f32x4 (&v)[8], const unsigned long long (&ra)[8], const unsigned long long (&rb)[8], const f32x4 (&ww)[8], float* xcopy, bf16_t* o, int lane) {
    float s = 0.f;
#pragma unroll
    for (int j = 0; j < 8; ++j) { v[j] = v[j] + (unpk4(ra[j]) + unpk4(rb[j])); s += (v[j].x * v[j].x + v[j].y * v[j].y) + (v[j].z * v[j].z + v[j].w * v[j].w); }
    const float r = rsqrtf(wave_sum(s) * (1.f / D) + EPS);
#pragma unroll
    for (int j = 0; j < 8; ++j) { ((f32x4*)xcopy)[lane + 64 * j] = v[j];
        const unsigned lo = pk2(v[j].x * r * ww[j].x, v[j].y * r * ww[j].y), hi = pk2(v[j].z * r * ww[j].z, v[j].w * r * ww[j].w);
        ((unsigned long long*)o)[lane + 64 * j] = (unsigned long long)lo | ((unsigned long long)hi << 32); }
}
DEVI void phase_rms(const Params& p, const float* w, int bid, int nb, bool first) {
    const int lane = otid() & 63, wave = otid() >> 6;
    float* X = (float*)(p.ws + WS_X); bf16_t* H = (bf16_t*)(p.ws + WS_H); const bf16_t* PA = (const bf16_t*)(p.ws + WS_PA); const bf16_t* PB = (const bf16_t*)(p.ws + WS_PB);
    f32x4 ww[8];
#pragma unroll
    for (int j = 0; j < 8; ++j) ww[j] = ((const f32x4*)w)[lane + 64 * j];
    const int NGW = nb * 8;
    for (int row = bid * 8 + wave; row < T; row += 2 * NGW) {
        const int row2 = row + NGW; const bool has2 = row2 < T;
        const float* srcA = first ? (row < TP ? p.in[0] + (size_t)row * D : p.in[1] + (size_t)(row - TP) * D) : X + (size_t)row * D;
        f32x4 va[8], vb[8]; unsigned long long aa[8], ab[8], ba[8], bb[8];
        rms2_load(srcA, PA + (size_t)row * D, PB + (size_t)row * D, row >> 8, lane, va, aa, ab);
        if (has2) { const float* srcB = first ? (row2 < TP ? p.in[0] + (size_t)row2 * D : p.in[1] + (size_t)(row2 - TP) * D) : X + (size_t)row2 * D;
            rms2_load(srcB, PA + (size_t)row2 * D, PB + (size_t)row2 * D, row2 >> 8, lane, vb, ba, bb); }
        rms2_finish(va, aa, ab, ww, X + (size_t)row * D, H + (size_t)row * D, lane);
        if (has2) rms2_finish(vb, ba, bb, ww, X + (size_t)row2 * D, H + (size_t)row2 * D, lane);
    }
}
DEVI void rms2_finish_f32(f32x4 (&v)[8], const unsigned long long (&ra)[8], const unsigned long long (&rb)[8], const f32x4 (&ww)[8], float* o, int lane) {
    float s = 0.f;
#pragma unroll
    for (int j = 0; j < 8; ++j) { v[j] = v[j] + (unpk4(ra[j]) + unpk4(rb[j])); s += (v[j].x * v[j].x + v[j].y * v[j].y) + (v[j].z * v[j].z + v[j].w * v[j].w); }
    const float r = rsqrtf(wave_sum(s) * (1.f / D) + EPS);
#pragma unroll
    for (int j = 0; j < 8; ++j) ((f32x4*)o)[lane + 64 * j] = (f32x4){v[j].x * r * ww[j].x, v[j].y * r * ww[j].y, v[j].z * r * ww[j].z, v[j].w * r * ww[j].w};
}
DEVI void phase_rms_final(const Params& p, int bid, int nb) {
    const int lane = otid() & 63, wave = otid() >> 6;
    const float* X = (const float*)(p.ws + WS_X); const bf16_t* PA = (const bf16_t*)(p.ws + WS_PA); const bf16_t* PB = (const bf16_t*)(p.ws + WS_PB);
    f32x4 ww[8];
#pragma unroll
    for (int j = 0; j < 8; ++j) ww[j] = ((const f32x4*)p.in[19])[lane + 64 * j];
    const int NGW = nb * 8;
    for (int row = bid * 8 + wave; row < T; row += 2 * NGW) {
        const int row2 = row + NGW; const bool has2 = row2 < T;
        f32x4 va[8], vb[8]; unsigned long long aa[8], ab[8], ba[8], bb[8];
        rms2_load(X + (size_t)row * D, PA + (size_t)row * D, PB + (size_t)row * D, row >> 8, lane, va, aa, ab);
        if (has2) rms2_load(X + (size_t)row2 * D, PA + (size_t)row2 * D, PB + (size_t)row2 * D, row2 >> 8, lane, vb, ba, bb);
        rms2_finish_f32(va, aa, ab, ww, p.out + O_YP + (size_t)row * D, lane);
        if (has2) rms2_finish_f32(vb, ba, bb, ww, p.out + O_YP + (size_t)row2 * D, lane);
    }
}

DEVI void phase_conv_a(const Params& p, int bid, int nb) {
    const bf16_t* P1 = (const bf16_t*)(p.ws + WS_ACT); bf16_t* GBp = (bf16_t*)(p.ws + WS_GB);
    const float* wcv = p.in[7]; const float* st = p.in[2];
    const int idx0 = bid * 512 + otid(), NT = nb * 512, c0 = (idx0 & 255) * 8;
    float w0[8], w1[8], w2[8]; ld8f(wcv + c0, w0); ld8f(wcv + 2048 + c0, w1); ld8f(wcv + 4096 + c0, w2);
    auto geom = [&](int idx, int& t, bool& smp, int& b, int& pos, int& L) { t = idx >> 8; smp = t >= TP; if (!smp) { b = t >> 11; pos = t & 2047; L = 2048; } else { const int s = t - TP; b = s >> 3; pos = s & 7; L = 8; } };
    auto load = [&](int idx, u32x4 (&r0)[3], u32x4 (&r1)[2], u32x4 (&r2)[2]) {
        int t, b, pos, L; bool smp; geom(idx, t, smp, b, pos, L);
        const bf16_t* row = P1 + (size_t)t * 6144 + c0;
        r0[0] = *(const u32x4*)(row); r0[1] = *(const u32x4*)(row + 2048); r0[2] = *(const u32x4*)(row + 4096);
        if (pos >= 1) { r1[0] = *(const u32x4*)(row - 6144 + 2048); r1[1] = *(const u32x4*)(row - 6144 + 4096); }
        else if (smp) { const float* s1 = st + (size_t)(b * 2 + 1) * 2048 + c0; r1[0] = *(const u32x4*)(s1); r1[1] = *(const u32x4*)(s1 + 4); }
        else { r1[0] = (u32x4){0u, 0u, 0u, 0u}; r1[1] = r1[0]; }
        if (pos >= 2) { r2[0] = *(const u32x4*)(row - 2 * 6144 + 2048); r2[1] = *(const u32x4*)(row - 2 * 6144 + 4096); }
        else if (smp) { const float* s2 = st + (size_t)(b * 2 + pos) * 2048 + c0; r2[0] = *(const u32x4*)(s2); r2[1] = *(const u32x4*)(s2 + 4); }
        else { r2[0] = (u32x4){0u, 0u, 0u, 0u}; r2[1] = r2[0]; }
    };
    auto decode = [&](const u32x4 (&r)[2], bool from_rows, float (&u)[8]) {
        if (from_rows) { float cc[8], xx[8]; unpack8(r[0], cc); unpack8(r[1], xx);
#pragma unroll
            for (int i = 0; i < 8; ++i) u[i] = cc[i] * xx[i]; }
        else { u[0] = __uint_as_float(r[0].x); u[1] = __uint_as_float(r[0].y); u[2] = __uint_as_float(r[0].z); u[3] = __uint_as_float(r[0].w);
               u[4] = __uint_as_float(r[1].x); u[5] = __uint_as_float(r[1].y); u[6] = __uint_as_float(r[1].z); u[7] = __uint_as_float(r[1].w); }
    };
    auto finish = [&](int idx, const u32x4 (&r0)[3], const u32x4 (&r1)[2], const u32x4 (&r2)[2]) {
        int t, b, pos, L; bool smp; geom(idx, t, smp, b, pos, L);
        float gb[8], u0[8], u1[8], u2[8];
        unpack8(r0[0], gb); { const u32x4 cx[2] = {r0[1], r0[2]}; decode(cx, true, u0); }
        decode(r1, pos >= 1, u1); decode(r2, pos >= 2, u2);
        float g[8];
#pragma unroll
        for (int i = 0; i < 8; ++i) g[i] = gb[i] * (w0[i] * u2[i] + w1[i] * u1[i] + w2[i] * u0[i]);
        *(u32x4*)(GBp + (size_t)t * 2048 + c0) = pack8(g);
        if (pos >= L - 2) { float* o = p.out + (smp ? O_CAS : O_CAP) + (size_t)(b * 2 + (pos - (L - 2))) * 2048 + c0; st8f(o, u0); }
    };
    for (int idx = idx0; idx < T * 256; idx += 2 * NT) {
        const int idxB = idx + NT; const bool hasB = idxB < T * 256;
        u32x4 a0[3], a1[2], a2[2], b0[3], b1[2], b2[2];
        load(idx, a0, a1, a2);
        if (hasB) load(idxB, b0, b1, b2);
        finish(idx, a0, a1, a2);
        if (hasB) finish(idxB, b0, b1, b2);
    }
}

DEVI void phase_g1(const Params& p, int bid, int nb) {
    unsigned char* ws = p.ws;
    const bf16_t* QKV = (const bf16_t*)(ws + WS_QKV);
    bf16_t* QN = (bf16_t*)(ws + WS_QN); bf16_t* KN = (bf16_t*)(ws + WS_KN); bf16_t* VS = (bf16_t*)(ws + WS_VS);
    bf16_t* KT = (bf16_t*)(ws + WS_KT); bf16_t* VT = (bf16_t*)(ws + WS_VT);
    const float* wcv = p.in[11]; const float* st = p.in[3];
    const int g1lane = otid() & 63, g1wave = otid() >> 6;
    const int ch0 = ((bid * 8 + g1wave) & 63) * 128 + (g1lane >> 2) * 8;
    float w0[8], w1[8], w2[8], w3[8]; ld8f(wcv + ch0, w0); ld8f(wcv + 8192 + ch0, w1); ld8f(wcv + 2 * 8192 + ch0, w2); ld8f(wcv + 3 * 8192 + ch0, w3);
    for (int wi = bid * 8 + g1wave; wi < (T / 32) * 64; wi += nb * 8) {
        const int t0 = (wi >> 6) * 32 + (g1lane & 3) * 8;
        const bool smp = t0 >= TP; int b, pos0;
        if (!smp) { b = t0 >> 11; pos0 = t0 & 2047; } else { b = (t0 - TP) >> 3; pos0 = 0; }
        float h0[8], h1[8], h2[8];
        if (pos0 > 0) { const bf16_t* r = QKV + (size_t)t0 * 8192 + ch0; unpack8(*(const u32x4*)(r - 3 * 8192), h0); unpack8(*(const u32x4*)(r - 2 * 8192), h1); unpack8(*(const u32x4*)(r - 8192), h2); }
        else if (smp) { const float* r = st + (size_t)b * 3 * 8192 + ch0; ld8f(r, h0); ld8f(r + 8192, h1); ld8f(r + 2 * 8192, h2); }
        else {
#pragma unroll
            for (int i = 0; i < 8; ++i) { h0[i] = 0.f; h1[i] = 0.f; h2[i] = 0.f; } }
        float y[8][8];
        const bool tailp = (!smp) && (pos0 == 2040);
        u32x4 xraw[8];
#pragma unroll
        for (int i = 0; i < 8; ++i) xraw[i] = *(const u32x4*)(QKV + (size_t)(t0 + i) * 8192 + ch0);
#pragma unroll
        for (int i = 0; i < 8; ++i) {
            float x[8]; unpack8(xraw[i], x);
#pragma unroll
            for (int c = 0; c < 8; ++c) { const float a = w0[c] * h0[c] + w1[c] * h1[c] + w2[c] * h2[c] + w3[c] * x[c]; y[i][c] = silu_f(a); h0[c] = h1[c]; h1[c] = h2[c]; h2[c] = x[c]; }
            if (i >= 5 && (smp || tailp)) { float* o = p.out + (smp ? O_CBS : O_CBP) + (size_t)(b * 3 + (i - 5)) * 8192 + ch0; st8f(o, x); }
        }
        if (ch0 < 4096) {
            const float sc = ch0 < 2048 ? 0.08838834764831845f : 1.f;
#pragma unroll
            for (int i = 0; i < 8; ++i) { float s = 0.f;
#pragma unroll
                for (int c = 0; c < 8; ++c) s += y[i][c] * y[i][c];
                s += __shfl_xor(s, 4); s += __shfl_xor(s, 8); s += __shfl_xor(s, 16); s += __shfl_xor(s, 32);
                const float r = rsqrtf(s + EPS) * sc;
#pragma unroll
                for (int c = 0; c < 8; ++c) y[i][c] *= r; }
        }
        if (ch0 < 2048) {
#pragma unroll
            for (int i = 0; i < 8; ++i) *(u32x4*)(QN + (size_t)(t0 + i) * 2048 + ch0) = pack8(y[i]);
        } else if (ch0 < 4096) {
            const int ck = ch0 - 2048;
#pragma unroll
            for (int i = 0; i < 8; ++i) *(u32x4*)(KN + (size_t)(t0 + i) * 2048 + ck) = pack8(y[i]);
            if (!smp) { const int n = pos0 >> 6, j0 = pos0 & 63, hk = ck >> 7, d0 = ck & 127;
                bf16_t* base = KT + ((size_t)((b * 32 + n) * 16 + hk) * 128 + d0) * 64 + j0;
#pragma unroll
                for (int c = 0; c < 8; ++c) { u32x4 w; w.x = pk2(y[0][c], y[1][c]); w.y = pk2(y[2][c], y[3][c]); w.z = pk2(y[4][c], y[5][c]); w.w = pk2(y[6][c], y[7][c]); *(u32x4*)(base + c * 64) = w; } }
        } else {
            const int cv = ch0 - 4096;
            if (smp) {
#pragma unroll
                for (int i = 0; i < 8; ++i) *(u32x4*)(VS + (size_t)(t0 - TP + i) * 4096 + cv) = pack8(y[i]);
            } else { const int n = pos0 >> 6, j0 = pos0 & 63, hv = cv >> 7, e0 = cv & 127;
                bf16_t* base = VT + ((size_t)((b * 32 + n) * 32 + hv) * 128 + e0) * 64 + j0;
#pragma unroll
                for (int c = 0; c < 8; ++c) { u32x4 w; w.x = pk2(y[0][c], y[1][c]); w.y = pk2(y[2][c], y[3][c]); w.z = pk2(y[4][c], y[5][c]); w.w = pk2(y[6][c], y[7][c]); *(u32x4*)(base + c * 64) = w; } }
        }
    }
    const float* BA = (const float*)(ws + WS_BA); float* BETA = (float*)(ws + WS_BETA); float* GG = (float*)(ws + WS_GG);
    for (int idx = bid * 512 + otid(); idx < T * 32; idx += nb * 512) {
        const int t = idx >> 5, h = idx & 31;
        const float br = BA[(size_t)t * 64 + h], ar = BA[(size_t)t * 64 + 32 + h];
        BETA[idx] = 1.f / (1.f + expf(-br));
        const float xs = ar + p.in[13][h];
        const float sp = fmaxf(xs, 0.f) + log1pf(expf(-fabsf(xs)));
        GG[idx] = -expf(p.in[12][h]) * sp;
    }
}

DEVI void phase_g2(const Params& p, unsigned char* lds, int bid, int nb) {
    unsigned char* ws = p.ws;
    const int lane0 = otid() & 63, wave = otid() >> 6;
    float* Am = (float*)(lds + wave * 16384);
    const bf16_t* QN = (const bf16_t*)(ws + WS_QN); const bf16_t* KN = (const bf16_t*)(ws + WS_KN);
    const bf16_t* KT = (const bf16_t*)(ws + WS_KT); const bf16_t* VT = (const bf16_t*)(ws + WS_VT);
    const float* BETA = (const float*)(ws + WS_BETA); const float* GG = (const float*)(ws + WS_GG); float* GC = (float*)(ws + WS_GC);
    bf16_t* UT = (bf16_t*)(ws + WS_UT); bf16_t* WW = (bf16_t*)(ws + WS_WW); bf16_t* QKM = (bf16_t*)(ws + WS_QKM);
    for (int it = bid * 8 + wave; it < 4096; it += nb * 8) {
        int lane = lane0; asm volatile("" : "+v"(lane));
        const int fr = lane & 15, fq = lane >> 4;
        const int b = it >> 10, n = (it >> 5) & 31, h = it & 31, hk = h >> 1, t0 = b * 2048 + n * 64;
        const size_t itemK = (size_t)((b * 32 + n) * 16 + hk);
        float gc = GG[(size_t)(t0 + lane) * 32 + h]; const float bt = BETA[(size_t)(t0 + lane) * 32 + h];
#pragma unroll
        for (int o = 1; o < 64; o <<= 1) { const float v = __shfl_up(gc, o); if (lane >= o) gc += v; }
        GC[(size_t)(t0 + lane) * 32 + h] = gc;
        const bf16_t* kbase = KN + (size_t)(t0 + fr) * 2048 + hk * 128 + 8 * fq;
        const bf16_t* qbase = QN + (size_t)(t0 + fr) * 2048 + hk * 128 + 8 * fq;
        {
            bf16x8 kf[4][4], qf[2][4];
#pragma unroll
            for (int m = 0; m < 4; ++m)
#pragma unroll
                for (int kk = 0; kk < 4; ++kk) kf[m][kk] = ldfrag(kbase + (size_t)(16 * m) * 2048 + 32 * kk);
#pragma unroll
            for (int m = 0; m < 4; ++m)
#pragma unroll
                for (int nn = 0; nn < 4; ++nn) {
                    f32x4 acc = {0.f, 0.f, 0.f, 0.f};
                    if (nn <= m) {
#pragma unroll
                        for (int kk = 0; kk < 4; ++kk) acc = mfma16(kf[m][kk], kf[nn][kk], acc); }
                    const int j = 16 * nn + fr; const float gj = __shfl(gc, j);
#pragma unroll
                    for (int jj = 0; jj < 4; ++jj) { const int i = 16 * m + 4 * fq + jj; const float gi = __shfl(gc, i), bi = __shfl(bt, i);
                        Am[i * 64 + j] = (i > j) ? -(bi * acc[jj] * __expf(gi - gj)) : 0.f; }
                }
            bf16_t* qkb = QKM + (size_t)it * 4096;
#pragma unroll
            for (int ni = 0; ni < 4; ++ni) { const int i = 16 * ni + fr; const float gi = __shfl(gc, i);
                if ((ni & 1) == 0) {
#pragma unroll
                    for (int m = 0; m < 2; ++m)
#pragma unroll
                        for (int kk = 0; kk < 4; ++kk) qf[m][kk] = ldfrag(qbase + (size_t)(16 * (ni + m)) * 2048 + 32 * kk); }
#pragma unroll
                for (int mj = 0; mj < 4; ++mj) {
                    f32x4 acc = {0.f, 0.f, 0.f, 0.f};
                    if (ni >= mj) {
#pragma unroll
                        for (int kk = 0; kk < 4; ++kk) acc = mfma16(kf[mj][kk], qf[ni & 1][kk], acc); }
                    float o[4];
#pragma unroll
                    for (int jj = 0; jj < 4; ++jj) { const int j = 16 * mj + 4 * fq + jj; const float gj = __shfl(gc, j); o[jj] = (i >= j) ? acc[jj] * __expf(gi - gj) : 0.f; }
                    *(unsigned long long*)(qkb + (size_t)i * 64 + 16 * mj + 4 * fq) = (unsigned long long)pk2(o[0], o[1]) | ((unsigned long long)pk2(o[2], o[3]) << 32);
                } }
        }
        WAVE_LDS_SYNC();
        bf16x8 vfr[8][2];
        { const bf16_t* vtb = VT + (size_t)it * 8192 + (size_t)fr * 64 + 8 * fq;
#pragma unroll
          for (int t8 = 0; t8 < 8; ++t8) { vfr[t8][0] = ldfrag(vtb + t8 * 1024); vfr[t8][1] = ldfrag(vtb + t8 * 1024 + 32); } }
        {
            float a[64];
#pragma unroll
            for (int i = 0; i < 64; ++i) a[i] = Am[i * 64 + lane];
            typedef float f32x2_t __attribute__((ext_vector_type(2)));
#pragma unroll
            for (int i = 2; i < 64; ++i) {
                const int rb = __float_as_int(a[i]); f32x2_t acc = {a[i], 0.f};
#pragma unroll
                for (int j = 1; j + 1 < i; j += 2) { const f32x2_t s = {__int_as_float(__builtin_amdgcn_readlane(rb, j)), __int_as_float(__builtin_amdgcn_readlane(rb, j + 1))};
                    const f32x2_t av = {a[j], a[j + 1]}; acc = __builtin_elementwise_fma(s, av, acc); }
                float r = acc.x + acc.y;
                if (((i - 1) & 1) != 0) r += __int_as_float(__builtin_amdgcn_readlane(rb, i - 1)) * a[i - 1];
                a[i] = r;
            }
#pragma unroll
            for (int i = 2; i < 64; ++i) Am[i * 64 + lane] = a[i];
        }
        WAVE_LDS_SYNC();
        {
            bf16x8 tp[4][2], tpp[4][2];
#pragma unroll
            for (int kk = 0; kk < 2; ++kk) {
                float bj[8], bg[8];
#pragma unroll
                for (int s = 0; s < 8; ++s) { const int j = 32 * kk + 8 * fq + s; bj[s] = __shfl(bt, j); bg[s] = bj[s] * __expf(__shfl(gc, j)); }
#pragma unroll
                for (int mi = 0; mi < 4; ++mi) { const int i = 16 * mi + fr; float tv[8]; ld8f(Am + i * 64 + 32 * kk + 8 * fq, tv);
                    float a[8], c[8];
#pragma unroll
                    for (int s = 0; s < 8; ++s) { const float t = tv[s] + ((i == 32 * kk + 8 * fq + s) ? 1.f : 0.f); a[s] = t * bj[s]; c[s] = t * bg[s]; }
                    const u32x4 pa = pack8(a), pc = pack8(c); tp[mi][kk] = __builtin_bit_cast(bf16x8, pa); tpp[mi][kk] = __builtin_bit_cast(bf16x8, pc); }
            }
            bf16_t* utb = UT + (size_t)it * 8192; bf16_t* stg = (bf16_t*)Am;
            WAVE_LDS_SYNC();
#pragma unroll
            for (int ne = 0; ne < 8; ++ne) {
#pragma unroll
                for (int mi = 0; mi < 4; ++mi) { f32x4 acc = {0.f, 0.f, 0.f, 0.f}; acc = mfma16(tp[mi][0], vfr[ne][0], acc); acc = mfma16(tp[mi][1], vfr[ne][1], acc);
                    *(unsigned long long*)(stg + (16 * ne + fr) * 64 + 16 * mi + 4 * fq) = (unsigned long long)pk2(acc[0], acc[1]) | ((unsigned long long)pk2(acc[2], acc[3]) << 32); } }
            WAVE_LDS_SYNC();
            { u32x4 tv[16];
#pragma unroll
              for (int q = 0; q < 16; ++q) tv[q] = *(const u32x4*)(stg + q * 512 + lane * 8);
#pragma unroll
              for (int q = 0; q < 16; ++q) *(u32x4*)(utb + q * 512 + lane * 8) = tv[q]; }
            WAVE_LDS_SYNC();
            bf16x8 kfr[8][2];
            { const bf16_t* ktb = KT + itemK * 8192 + (size_t)fr * 64 + 8 * fq;
#pragma unroll
              for (int t8 = 0; t8 < 8; ++t8) { kfr[t8][0] = ldfrag(ktb + t8 * 1024); kfr[t8][1] = ldfrag(ktb + t8 * 1024 + 32); } }
            bf16_t* wwb = WW + (size_t)it * 8192;
#pragma unroll
            for (int md = 0; md < 8; ++md) {
#pragma unroll
                for (int ni = 0; ni < 4; ++ni) { f32x4 acc = {0.f, 0.f, 0.f, 0.f}; acc = mfma16(kfr[md][0], tpp[ni][0], acc); acc = mfma16(kfr[md][1], tpp[ni][1], acc);
                    *(unsigned long long*)(stg + (16 * ni + fr) * 128 + 16 * md + 4 * fq) = (unsigned long long)pk2(acc[0], acc[1]) | ((unsigned long long)pk2(acc[2], acc[3]) << 32); } }
            WAVE_LDS_SYNC();
            { u32x4 tv[16];
#pragma unroll
              for (int q = 0; q < 16; ++q) tv[q] = *(const u32x4*)(stg + q * 512 + lane * 8);
#pragma unroll
              for (int q = 0; q < 16; ++q) *(u32x4*)(wwb + q * 512 + lane * 8) = tv[q]; }
        }
        WAVE_LDS_SYNC();
    }
}

template <bool DIAG> DEVI void g3_chain(const Params& p, unsigned char* lds, int item_bh) {
    unsigned char* ws = p.ws;
    const int tid = otid(), lane = tid & 63, w = tid >> 6, fr = lane & 15, fq = lane >> 4;
    const int b = item_bh >> 5, h = item_bh & 31, hk = h >> 1, m = w & 3, eh = w >> 2;
    bf16_t* St = (bf16_t*)lds; bf16_t* VNT = (bf16_t*)(lds + 34816); bf16_t* VNS = (bf16_t*)(lds + 34816 + 18432); float* RED = (float*)(lds + 34816 + 2 * 18432);
    const bf16_t* QN = (const bf16_t*)(ws + WS_QN); const bf16_t* KT = (const bf16_t*)(ws + WS_KT);
    const bf16_t* UT = (const bf16_t*)(ws + WS_UT); const bf16_t* WW = (const bf16_t*)(ws + WS_WW); const bf16_t* QKM = (const bf16_t*)(ws + WS_QKM);
    const float* GC = (const float*)(ws + WS_GC); const bf16_t* Z = (const bf16_t*)(ws + WS_Z); bf16_t* OG = (bf16_t*)(ws + WS_OG);
    const float* onorm = p.in[14];
    f32x4 s[2][4];
#pragma unroll
    for (int a = 0; a < 2; ++a)
#pragma unroll
        for (int c = 0; c < 4; ++c) { s[a][c] = (f32x4){0.f, 0.f, 0.f, 0.f};
            *(unsigned long long*)(St + (size_t)(16 * (4 * eh + c) + fr) * 136 + 16 * (2 * m + a) + 4 * fq) = 0ull; }
    LDS_BARRIER();
    float on[4];
#pragma unroll
    for (int ne = 0; ne < 4; ++ne) on[ne] = onorm[16 * (4 * eh + ne) + fr];
    bf16x8 wf[4], qf[4], qkf[2], ktf[2][2]; float gi[4], gl;
    bf16x8 nwf[4], nqf[4], nqkf[2], nktf[2][2]; float ngi[4], ngl;
    PG8_LAS unsigned char* dma = (PG8_LAS unsigned char*)lds + 73728 + w * 8192;
#define CHAIN_LOAD_A(WF, QF, QKF, KTF, GI, GL, n_) do { \
        const size_t item_ = (size_t)((b * 32 + (n_)) * 32 + h), itemK_ = (size_t)((b * 32 + (n_)) * 16 + hk); const int t0_ = b * 2048 + (n_) * 64; \
        _Pragma("unroll") for (int k2 = 0; k2 < 2; ++k2) { QKF[k2] = ldfrag(QKM + item_ * 4096 + (size_t)(16 * m + fr) * 64 + 32 * k2 + 8 * fq); \
            _Pragma("unroll") for (int a = 0; a < 2; ++a) KTF[a][k2] = ldfrag(KT + itemK_ * 8192 + (size_t)(16 * (2 * m + a) + fr) * 64 + 32 * k2 + 8 * fq); } \
        _Pragma("unroll") for (int kk = 0; kk < 4; ++kk) { WF[kk] = ldfrag(WW + item_ * 8192 + (size_t)(16 * m + fr) * 128 + 32 * kk + 8 * fq); QF[kk] = ldfrag(QN + (size_t)(t0_ + 16 * m + fr) * 2048 + hk * 128 + 32 * kk + 8 * fq); } \
        _Pragma("unroll") for (int jj = 0; jj < 4; ++jj) GI[jj] = GC[(size_t)(t0_ + 16 * m + 4 * fq + jj) * 32 + h]; \
        GL = GC[(size_t)(t0_ + 63) * 32 + h]; } while (0)
#define CHAIN_DMA(n_, buf_) do { \
        const size_t item_ = (size_t)((b * 32 + (n_)) * 32 + h); const int t0_ = b * 2048 + (n_) * 64; \
        _Pragma("unroll") for (int q = 0; q < 2; ++q) { const int pi = q * 64 + lane; \
            __builtin_amdgcn_global_load_lds((const unsigned*)(UT + item_ * 8192 + (size_t)(64 * eh + (pi >> 1)) * 64 + 16 * m + 8 * (pi & 1)), (PG8_LAS unsigned*)(dma + (buf_) * 4096 + q * 1024), 16, 0, 0); \
            __builtin_amdgcn_global_load_lds((const unsigned*)(Z + (size_t)(t0_ + 16 * m + (pi >> 3)) * 4096 + h * 128 + 64 * eh + 8 * (pi & 7)), (PG8_LAS unsigned*)(dma + (buf_) * 4096 + 2048 + q * 1024), 16, 0, 0); } \
        asm volatile("" ::: "memory"); } while (0)
    if constexpr (!DIAG) CHAIN_DMA(0, 0);
    CHAIN_LOAD_A(wf, qf, qkf, ktf, gi, gl, 0);
    auto chain_body = [&](const int n, auto FIRST_, auto LAST_) {
        constexpr bool FIRST = decltype(FIRST_)::value, LAST = decltype(LAST_)::value;
        const int t0 = b * 2048 + n * 64;
        f32x4 P[4], O1[4];
#pragma unroll
        for (int ne = 0; ne < 4; ++ne) { P[ne] = (f32x4){0.f, 0.f, 0.f, 0.f}; O1[ne] = (f32x4){0.f, 0.f, 0.f, 0.f};
#pragma unroll
            for (int kk = 0; kk < 4; ++kk) { const bf16x8 bf = ldfrag(St + (size_t)(16 * (4 * eh + ne) + fr) * 136 + 32 * kk + 8 * fq); P[ne] = mfma16(wf[kk], bf, P[ne]); O1[ne] = mfma16(qf[kk], bf, O1[ne]); } }
        if constexpr (!LAST && !DIAG) CHAIN_DMA(n + 1, (n + 1) & 1);
        if constexpr (!LAST && !DIAG) CHAIN_LOAD_A(nwf, nqf, nqkf, nktf, ngi, ngl, n + 1);
        unsigned long long ut[4];
#pragma unroll
        for (int ne = 0; ne < 4; ++ne) ut[ne] = *(const PG8_LAS unsigned long long*)(dma + (n & 1) * 4096 + ((16 * ne + fr) * 2 + (fq >> 1)) * 16 + (fq & 1) * 8);
        float eg[4], ed[4];
#pragma unroll
        for (int jj = 0; jj < 4; ++jj) { eg[jj] = __expf(gi[jj]); ed[jj] = __expf(gl - gi[jj]); }
#pragma unroll
        for (int ne = 0; ne < 4; ++ne) { float vn[4];
            vn[0] = bf2f((unsigned short)(ut[ne] & 0xffffu)) - P[ne][0]; vn[1] = bf2f((unsigned short)((ut[ne] >> 16) & 0xffffu)) - P[ne][1];
            vn[2] = bf2f((unsigned short)((ut[ne] >> 32) & 0xffffu)) - P[ne][2]; vn[3] = bf2f((unsigned short)((ut[ne] >> 48) & 0xffffu)) - P[ne][3];
            const size_t off = (size_t)(16 * (4 * eh + ne) + fr) * 72 + 16 * m + 4 * fq;
            *(unsigned long long*)(VNT + off) = (unsigned long long)pk2(vn[0], vn[1]) | ((unsigned long long)pk2(vn[2], vn[3]) << 32);
            *(unsigned long long*)(VNS + off) = (unsigned long long)pk2(vn[0] * ed[0], vn[1] * ed[1]) | ((unsigned long long)pk2(vn[2] * ed[2], vn[3] * ed[3]) << 32);
#pragma unroll
            for (int jj = 0; jj < 4; ++jj) O1[ne][jj] *= eg[jj]; }
        LDS_BARRIER();
#pragma unroll
        for (int ne = 0; ne < 4; ++ne)
#pragma unroll
            for (int k2 = 0; k2 < 2; ++k2) { const bf16x8 bf = ldfrag(VNT + (size_t)(16 * (4 * eh + ne) + fr) * 72 + 32 * k2 + 8 * fq); O1[ne] = mfma16(qkf[k2], bf, O1[ne]); }
        float ss[4];
#pragma unroll
        for (int jj = 0; jj < 4; ++jj) { float v = O1[0][jj] * O1[0][jj] + O1[1][jj] * O1[1][jj] + O1[2][jj] * O1[2][jj] + O1[3][jj] * O1[3][jj];
            v += __shfl_xor(v, 1); v += __shfl_xor(v, 2); v += __shfl_xor(v, 4); v += __shfl_xor(v, 8); ss[jj] = v; }
        if (fr == 0) {
#pragma unroll
            for (int jj = 0; jj < 4; ++jj) RED[eh * 64 + 16 * m + 4 * fq + jj] = ss[jj]; }
        const float egl = __expf(gl);
#pragma unroll
        for (int a = 0; a < 2; ++a)
#pragma unroll
            for (int ne = 0; ne < 4; ++ne) { s[a][ne] = s[a][ne] * egl;
#pragma unroll
                for (int k2 = 0; k2 < 2; ++k2) { const bf16x8 bf = ldfrag(VNS + (size_t)(16 * (4 * eh + ne) + fr) * 72 + 32 * k2 + 8 * fq); s[a][ne] = mfma16(ktf[a][k2], bf, s[a][ne]); } }
        LDS_BARRIER();
#pragma unroll
        for (int a = 0; a < 2; ++a)
#pragma unroll
            for (int ne = 0; ne < 4; ++ne)
                *(unsigned long long*)(St + (size_t)(16 * (4 * eh + ne) + fr) * 136 + 16 * (2 * m + a) + 4 * fq) = (unsigned long long)pk2(s[a][ne][0], s[a][ne][1]) | ((unsigned long long)pk2(s[a][ne][2], s[a][ne][3]) << 32);
#pragma unroll
        for (int jj = 0; jj < 4; ++jj) { const int i = 16 * m + 4 * fq + jj; const float r = rsqrtf((RED[i] + RED[64 + i]) * (1.f / 128.f) + EPS);
            const size_t ro = (size_t)(t0 + i) * 4096 + h * 128;
#pragma unroll
            for (int ne = 0; ne < 4; ++ne) { const int e = 16 * (4 * eh + ne) + fr; const float z = bf2f(*(const PG8_LAS unsigned short*)(dma + (n & 1) * 4096 + 2048 + ((4 * fq + jj) * 8 + 2 * ne + (fr >> 3)) * 16 + (fr & 7) * 2));
                const unsigned short ov = f2bf(O1[ne][jj] * r * on[ne] * silu_f(z)); if constexpr (!DIAG) OG[ro + e] = ov; else asm volatile("" :: "v"((unsigned)ov)); } }
#pragma unroll
        for (int kk = 0; kk < 4; ++kk) { if constexpr (!DIAG) { wf[kk] = nwf[kk]; qf[kk] = nqf[kk]; gi[kk] = ngi[kk]; } }
        if constexpr (!DIAG) { gl = ngl; qkf[0] = nqkf[0]; qkf[1] = nqkf[1]; ktf[0][0] = nktf[0][0]; ktf[0][1] = nktf[0][1]; ktf[1][0] = nktf[1][0]; ktf[1][1] = nktf[1][1]; }
        LDS_BARRIER();
    };
    chain_body(0, std::true_type{}, std::false_type{});
#pragma unroll 1
    for (int n = 1; n < 31; ++n) chain_body(n, std::false_type{}, std::false_type{});
    chain_body(31, std::false_type{}, std::true_type{});
#undef CHAIN_LOAD_A
#undef CHAIN_DMA
    if constexpr (DIAG) { asm volatile("" :: "v"(s[0][0][0]), "v"(s[1][3][3])); return; }
    float* so = p.out + O_SSP + (size_t)item_bh * 16384;
#pragma unroll
    for (int a = 0; a < 2; ++a)
#pragma unroll
        for (int ne = 0; ne < 4; ++ne)
#pragma unroll
            for (int jj = 0; jj < 4; ++jj) so[(size_t)(16 * (2 * m + a) + 4 * fq + jj) * 128 + 16 * (4 * eh + ne) + fr] = s[a][ne][jj];
}

template <bool DIAG> DEVI void g3_sample(const Params& p, unsigned char* lds, int first, int stride, int end) {
    unsigned char* ws = p.ws;
    const int tid0 = otid();
    bf16_t* St = (bf16_t*)lds;
    constexpr int KS = 136;
    float* KF = (float*)(lds + 34816); float* QF = KF + 8 * KS; float* VF = QF + 8 * KS;
    float* SM = VF + 8 * KS;
    float* gcs = SM; float* bts = SM + 8; float* M1 = SM + 16; float* QKs = SM + 80; float* Tm = SM + 144;
    bf16_t* AW = (bf16_t*)(SM + 256);
    float* UF = (float*)((unsigned char*)AW + 16 * 136 * 2);
    bf16_t* KDT = (bf16_t*)(UF + 1024);
    bf16_t* VNT = KDT + 1024;
    float* RED = (float*)(VNT + 1024);
    float* WSQ = RED + 64;
    const bf16_t* QN = (const bf16_t*)(ws + WS_QN); const bf16_t* KN = (const bf16_t*)(ws + WS_KN); const bf16_t* VS = (const bf16_t*)(ws + WS_VS);
    const float* BETA = (const float*)(ws + WS_BETA); const float* GG = (const float*)(ws + WS_GG);
    const bf16_t* Z = (const bf16_t*)(ws + WS_Z); bf16_t* OG = (bf16_t*)(ws + WS_OG);
    const float* s0 = p.in[4]; const float* onorm = p.in[14];
    f32x4 sreg[8], snext[8];
    unsigned pk = 0, pq = 0, pv = 0, pz0 = 0, pz1 = 0; float pg = 0.f, pb = 0.f;
#define SAMPLE_PREFETCH(it_) do { const int bs_ = (it_) >> 5, h_ = (it_) & 31, hk_ = h_ >> 1, tS_ = TP + bs_ * 8; const int i_ = tid >> 6, d2_ = (tid & 63) * 2; \
        pk = *(const unsigned*)(KN + (size_t)(tS_ + i_) * 2048 + hk_ * 128 + d2_); pq = *(const unsigned*)(QN + (size_t)(tS_ + i_) * 2048 + hk_ * 128 + d2_); \
        pv = *(const unsigned*)(VS + (size_t)(bs_ * 8 + i_) * 4096 + h_ * 128 + d2_); \
        if (tid < 8) { pg = GG[(size_t)(tS_ + tid) * 32 + h_]; pb = BETA[(size_t)(tS_ + tid) * 32 + h_]; } \
        pz0 = Z[(size_t)(tS_ + 2 * fq) * 4096 + h_ * 128 + 16 * w + fr]; pz1 = Z[(size_t)(tS_ + 2 * fq + 1) * 4096 + h_ * 128 + 16 * w + fr]; } while (0)
    { const int tid = tid0, lane = tid & 63, w = tid >> 6, fr = lane & 15, fq = lane >> 4; (void)lane;
    if (first < end) {
#pragma unroll
        for (int mm = 0; mm < 8; ++mm) sreg[mm] = *(const f32x4*)(s0 + (size_t)first * 16384 + (size_t)(16 * mm + fr) * 128 + 16 * w + 4 * fq);
        SAMPLE_PREFETCH(first);
    }
    }
    auto sample_body = [&](const int it, auto FIRST_, auto LAST_) {
        constexpr bool FIRST = decltype(FIRST_)::value, LAST = decltype(LAST_)::value;
        int tid = tid0; asm volatile("" : "+v"(tid));
        const int lane = tid & 63, w = tid >> 6, fr = lane & 15, fq = lane >> 4;
        const int bs = it >> 5, h = it & 31, hk = h >> 1, tS = TP + bs * 8;
#pragma unroll
        for (int mm = 0; mm < 8; ++mm)
#pragma unroll
            for (int jj = 0; jj < 4; ++jj) St[(size_t)(16 * w + 4 * fq + jj) * 136 + 16 * mm + fr] = f2bf(sreg[mm][jj]);
        if constexpr (!LAST && !DIAG) {
#pragma unroll
            for (int mm = 0; mm < 8; ++mm) snext[mm] = *(const f32x4*)(s0 + (size_t)(it + stride) * 16384 + (size_t)(16 * mm + fr) * 128 + 16 * w + 4 * fq);
        }
        { const int i = tid >> 6, d2 = (tid & 63) * 2;
          KF[i * KS + d2] = __uint_as_float(pk << 16); KF[i * KS + d2 + 1] = __uint_as_float(pk & 0xffff0000u);
          QF[i * KS + d2] = __uint_as_float(pq << 16); QF[i * KS + d2 + 1] = __uint_as_float(pq & 0xffff0000u);
          VF[i * KS + d2] = __uint_as_float(pv << 16); VF[i * KS + d2 + 1] = __uint_as_float(pv & 0xffff0000u); }
        if (w == 0) { float g = (tid < 8) ? pg : 0.f;
#pragma unroll
            for (int o = 1; o < 8; o <<= 1) { const float v = __shfl_up(g, o); if (lane >= o) g += v; }
            if (tid < 8) { gcs[tid] = g; bts[tid] = pb; } }
        const float zc0 = __uint_as_float(pz0 << 16), zc1 = __uint_as_float(pz1 << 16);
        if constexpr (!LAST && !DIAG) SAMPLE_PREFETCH(it + stride);
        LDS_BARRIER();
        { const int pid = tid >> 3, i = pid >> 3, j = pid & 7, part = tid & 7; float kkv = 0.f, qkv = 0.f;
#pragma unroll
          for (int d = 0; d < 16; ++d) { const float kj = KF[j * KS + part + 8 * d]; kkv += KF[i * KS + part + 8 * d] * kj; qkv += QF[i * KS + part + 8 * d] * kj; }
          kkv += __shfl_xor(kkv, 1); kkv += __shfl_xor(kkv, 2); kkv += __shfl_xor(kkv, 4);
          qkv += __shfl_xor(qkv, 1); qkv += __shfl_xor(qkv, 2); qkv += __shfl_xor(qkv, 4);
          if (part == 0) { const float dg = gcs[i] - gcs[j]; const float e = (i >= j) ? __expf(dg) : 0.f;
              M1[i * 8 + j] = (i > j) ? bts[i] * kkv * e : 0.f; QKs[i * 8 + j] = qkv * e; } }
        LDS_BARRIER();
        if (tid < 8) { float x[8];
#pragma unroll
            for (int i = 0; i < 8; ++i) { float a = (i == tid) ? 1.f : 0.f;
#pragma unroll
                for (int j = 0; j < 8; ++j) if (j < i) a -= M1[i * 8 + j] * x[j];
                x[i] = a; Tm[i * 8 + tid] = a; } }
        LDS_BARRIER();
#pragma unroll
        for (int r = 0; r < 2; ++r) { const int idx = tid + 512 * r, i = idx >> 7, e = idx & 127; float a = 0.f, c = 0.f;
#pragma unroll
            for (int j = 0; j < 8; ++j) { const float tb = Tm[i * 8 + j] * bts[j]; a += tb * VF[j * KS + e]; c += tb * __expf(gcs[j]) * KF[j * KS + e]; }
            UF[idx] = a; AW[i * 136 + e] = f2bf(c); AW[(8 + i) * 136 + e] = f2bf(QF[i * KS + e]);
            KDT[e * 8 + i] = f2bf(KF[i * KS + e] * __expf(gcs[7] - gcs[i])); }
        LDS_BARRIER();
        { f32x4 acc = {0.f, 0.f, 0.f, 0.f};
#pragma unroll
          for (int kk = 0; kk < 4; ++kk) acc = mfma16(ldfrag(AW + fr * 136 + 32 * kk + 8 * fq), ldfrag(St + (size_t)(16 * w + fr) * 136 + 32 * kk + 8 * fq), acc);
#pragma unroll
          for (int jj = 0; jj < 4; ++jj) WSQ[(4 * fq + jj) * 128 + 16 * w + fr] = acc[jj]; }
        WAVE_LDS_SYNC();
        const int e = 16 * w + fr;
        float vn[8], o2[2];
#pragma unroll
        for (int j = 0; j < 8; ++j) vn[j] = UF[j * 128 + e] - WSQ[j * 128 + e];
        if (fq == 0) *(u32x4*)(VNT + e * 8) = pack8(vn);
#pragma unroll
        for (int r = 0; r < 2; ++r) { const int i = 2 * fq + r; float o = __expf(gcs[i]) * WSQ[(8 + i) * 128 + e];
#pragma unroll
            for (int j = 0; j < 8; ++j) o += QKs[i * 8 + j] * vn[j];
            o2[r] = o; float v = o * o; v += __shfl_xor(v, 1); v += __shfl_xor(v, 2); v += __shfl_xor(v, 4); v += __shfl_xor(v, 8);
            if (fr == 0) RED[w * 8 + i] = v; }
        LDS_BARRIER();
#pragma unroll
        for (int r = 0; r < 2; ++r) { const int i = 2 * fq + r; float tot = 0.f;
#pragma unroll
            for (int ww = 0; ww < 8; ++ww) tot += RED[ww * 8 + i];
            const float rr = rsqrtf(tot * (1.f / 128.f) + EPS); const float z = r ? zc1 : zc0;
            const unsigned short ov = f2bf(o2[r] * rr * onorm[e] * silu_f(z)); if constexpr (!DIAG) OG[(size_t)(tS + i) * 4096 + h * 128 + e] = ov; else asm volatile("" :: "v"((unsigned)ov)); }
        { const float egl = __expf(gcs[7]); bf16x8 af = {0, 0, 0, 0, 0, 0, 0, 0};
          if (fq == 0) af = ldfrag(VNT + (size_t)(16 * w + fr) * 8);
          float* so = p.out + O_SSS + (size_t)it * 16384;
#pragma unroll
          for (int mm = 0; mm < 8; ++mm) { bf16x8 bf = {0, 0, 0, 0, 0, 0, 0, 0}; if (fq == 0) bf = ldfrag(KDT + (size_t)(16 * mm + fr) * 8);
              f32x4 acc = sreg[mm] * egl; acc = mfma16(af, bf, acc);
              if constexpr (!DIAG) *(f32x4*)(so + (size_t)(16 * mm + fr) * 128 + 16 * w + 4 * fq) = acc; else asm volatile("" :: "v"(acc[0]), "v"(acc[3])); } }
#pragma unroll
        for (int mm = 0; mm < 8; ++mm) { if constexpr (!DIAG) sreg[mm] = snext[mm]; }
        LDS_BARRIER();
    };
    const int nit = (first < end) ? (end - first + stride - 1) / stride : 0;
    if (nit == 1) sample_body(first, std::true_type{}, std::true_type{});
    else if (nit >= 2) {
        sample_body(first, std::true_type{}, std::false_type{});
#pragma unroll 1
        for (int q = 1; q + 1 < nit; ++q) sample_body(first + q * stride, std::false_type{}, std::false_type{});
        sample_body(first + (nit - 1) * stride, std::false_type{}, std::true_type{});
    }
}
#undef SAMPLE_PREFETCH
#ifndef G3_SECOND_MODE
#define G3_SECOND_MODE 0
#endif
DEVI void phase_g3(const Params& p, unsigned char* lds, int bid, int nb, int rep) {
    const int mode = rep ? G3_SECOND_MODE : 0;
    if (bid < NCHAIN) { if (mode == 0 || mode == 1) { for (int c = bid; c < 128; c += NCHAIN) g3_chain<false>(p, lds, c); LDS_BARRIER(); g3_sample<false>(p, lds, NS_A + bid, NCHAIN, 4096); }
#if G3_SECOND_MODE == 3
        else if (mode == 3) { for (int c = bid; c < 128; c += NCHAIN) g3_chain<true>(p, lds, c); }
#endif
    } else { if (mode == 0 || mode == 2) g3_sample<false>(p, lds, bid - NCHAIN, nb - NCHAIN, NS_A);
#if G3_SECOND_MODE == 4
        else if (mode == 4) g3_sample<true>(p, lds, bid - NCHAIN, nb - NCHAIN, NS_A);
#endif
    }
}

constexpr int NPHASES = 17;
template <int PH> DEVI void run_phase(const Params& p, unsigned char* lds, int bid, int nb, int rep = 0) {
    unsigned char* ws = p.ws;
    bf16_t* H = (bf16_t*)(ws + WS_H); bf16_t* ACT = (bf16_t*)(ws + WS_ACT); float* X = (float*)(ws + WS_X);
    if constexpr (PH == 0) phase0(p, lds, bid, nb);
    else if constexpr (PH == 1) { EpiBf16<0> E; E.O = ACT; E.ldc = 6144; run_gemm(lds, H, (const bf16_t*)(ws + WS_WT_INA), 6144, 2048, E, bid, nb);
        if (nb == 256 && bid >= 96 && rep == 0) { LDS_BARRIER(); convert_tiles(p, lds, CV_P0_END + (bid - 96), 160, CV_G1_END); } }
    else if constexpr (PH == 2) phase_conv_a(p, bid, nb);
    else if constexpr (PH == 3) run_gemm_sk(lds, (const bf16_t*)(ws + WS_GB), (const bf16_t*)(ws + WS_WT_OUTA), 2048, (bf16_t*)(ws + WS_PA), (bf16_t*)(ws + WS_PB), bid, nb);
    else if constexpr (PH == 4) phase_rms(p, p.in[16], bid, nb, true);
    else if constexpr (PH == 5) { EpiBf16<1> E; E.O = ACT; E.ldc = 8192; run_gemm(lds, H, (const bf16_t*)(ws + WS_WT_UP0), 8192, 2048, E, bid, nb);
        if (nb == 256 && bid >= 128 && rep == 0) { LDS_BARRIER(); convert_tiles(p, lds, CV_G1_END + (bid - 128), 128, CV_NST); } }
    else if constexpr (PH == 6) run_gemm_sk(lds, ACT, (const bf16_t*)(ws + WS_WT_DN0), 8192, (bf16_t*)(ws + WS_PA), (bf16_t*)(ws + WS_PB), bid, nb);
    else if constexpr (PH == 7) phase_rms(p, p.in[9], bid, nb, false);
    else if constexpr (PH == 8) { EpiProj E; E.QKV = (bf16_t*)(ws + WS_QKV); E.Z = (bf16_t*)(ws + WS_Z); E.BA = (float*)(ws + WS_BA); run_gemm(lds, H, (const bf16_t*)(ws + WS_WT_INB), NPROJ_PAD, 2048, E, bid, nb); }
    else if constexpr (PH == 9) phase_g1(p, bid, nb);
    else if constexpr (PH == 10) phase_g2(p, lds, bid, nb);
    else if constexpr (PH == 11) phase_g3(p, lds, bid, nb, rep);
    else if constexpr (PH == 12) run_gemm_sk(lds, (const bf16_t*)(ws + WS_OG), (const bf16_t*)(ws + WS_WT_OUTB), 4096, (bf16_t*)(ws + WS_PA), (bf16_t*)(ws + WS_PB), bid, nb);
    else if constexpr (PH == 13) phase_rms(p, p.in[16] + D, bid, nb, false);
    else if constexpr (PH == 14) { EpiBf16<1> E; E.O = ACT; E.ldc = 8192; run_gemm(lds, H, (const bf16_t*)(ws + WS_WT_UP1), 8192, 2048, E, bid, nb); }
    else if constexpr (PH == 15) run_gemm_sk(lds, ACT, (const bf16_t*)(ws + WS_WT_DN1), 8192, (bf16_t*)(ws + WS_PA), (bf16_t*)(ws + WS_PB), bid, nb);
    else if constexpr (PH == 16) phase_rms_final(p, bid, nb);
}

#if MEGA
#ifndef REPS_INIT
#define REPS_INIT {1,1,1,1,1,1,1,1,1,1,1,1,1,1,1,1,1}
#endif
__device__ constexpr int kReps[NPHASES] = REPS_INIT;
template <int PH> DEVI void mega_phases(const Params& p, unsigned char* shm, cg::grid_group& grid, const XcdBarrier& xb, int bid, int nb) {
#pragma unroll 1
    for (int r = 0; r < kReps[PH]; ++r) { run_phase<PH>(p, shm, bid, nb, r);
        if (PH + 1 < NPHASES || r + 1 < kReps[PH]) xcd_barrier(xb); }
    if constexpr (PH + 1 < NPHASES) mega_phases<PH + 1>(p, shm, grid, xb, bid, nb);
}
__global__ void __launch_bounds__(512, 2) k_mega(Params p) {
    extern __shared__ __attribute__((aligned(16))) unsigned char shm[];
    cg::grid_group grid = cg::this_grid();
    if (gridDim.x == 0x7fffffffu) grid.sync();
    if (threadIdx.x < 4) ((LAS unsigned*)(shm + LDS_XB))[threadIdx.x] = 0u;
    __syncthreads();
    const XcdBarrier xb = xcd_barrier_post((unsigned*)(p.ws + WS_BAR), (volatile LAS unsigned*)(shm + LDS_XB));
    mega_phases<0>(p, shm, grid, xb, (int)blockIdx.x, (int)gridDim.x);
}
#else
template <int PH> __global__ void __launch_bounds__(512, 2) k_phase(Params p) {
    extern __shared__ __attribute__((aligned(16))) unsigned char shm[];
    run_phase<PH>(p, shm, blockIdx.x, gridDim.x);
}
template <int PH> static void launch_phase(const Params& p, int grid, hipStream_t stream) {
    static bool attr = false;
    if (!attr) { (void)hipFuncSetAttribute((const void*)k_phase<PH>, hipFuncAttributeMaxDynamicSharedMemorySize, LDS_BYTES); attr = true; }
    hipLaunchKernelGGL(k_phase<PH>, dim3(grid), dim3(512), LDS_BYTES, stream, p);
}
template <int PH> static void launch_all(const Params& p, int grid, hipStream_t stream) {
    launch_phase<PH>(p, grid, stream);
    if constexpr (PH + 1 < NPHASES) launch_all<PH + 1>(p, grid, stream);
}
#endif

extern "C" void kernel_launch(void* const* d_in, const int* in_sizes, int n_in, void* d_out, int out_size, void* d_ws, size_t ws_size, hipStream_t stream) {
    static int grid = 0;
    if (grid == 0) {
        if (n_in != 20 || ws_size < WS_END) { fprintf(stderr, "kernel_launch: need 20 inputs and %zu bytes of workspace (got %d, %zu)\n", (size_t)WS_END, n_in, ws_size); grid = -1; return; }
        int dev = 0, cus = 0, per_cu = 0;
        (void)hipGetDevice(&dev); (void)hipDeviceGetAttribute(&cus, hipDeviceAttributeMultiprocessorCount, dev);
#if MEGA
        if (hipFuncSetAttribute((const void*)k_mega, hipFuncAttributeMaxDynamicSharedMemorySize, LDS_BYTES) != hipSuccess) { fprintf(stderr, "kernel_launch: hipFuncSetAttribute failed\n"); grid = -1; return; }
        if (hipOccupancyMaxActiveBlocksPerMultiprocessor(&per_cu, (const void*)k_mega, 512, LDS_BYTES) != hipSuccess || per_cu < 1) { fprintf(stderr, "kernel_launch: occupancy query says %d blocks per CU\n", per_cu); grid = -1; return; }
#endif
        grid = cus;
        if (grid < NCHAIN + 1) { fprintf(stderr, "kernel_launch: %d CUs is too few\n", grid); grid = -1; return; }
    }
    if (grid < 0) return;
    Params p{};
    for (int i = 0; i < 20; ++i) p.in[i] = (const float*)d_in[i];
    p.out = (float*)d_out; p.ws = (unsigned char*)d_ws;
#if MEGA
    if (hipMemsetAsync((unsigned char*)d_ws + WS_BAR, 0, 16384, stream) != hipSuccess) { fprintf(stderr, "kernel_launch: hipMemsetAsync of the barrier words failed\n"); return; }
    void* args[] = {&p};
    hipError_t e = hipLaunchCooperativeKernel((const void*)k_mega, dim3(grid), dim3(512), args, LDS_BYTES, stream);
    if (e != hipSuccess) fprintf(stderr, "kernel_launch: cooperative launch failed: %s (grid %d)\n", hipGetErrorString(e), grid);
#else
    launch_all<0>(p, grid, stream);
#endif
}
```
